# Optimizing an MI355X kernel written in HIP

```python
import math
import jax, jax.numpy as jnp
from jax import lax
import numpy as np

D_MODEL = 2048
BATCH = 1
SEQ = 8192
DEPTH = 4

CHUNK = 64
N_A_LAYERS = DEPTH // 2
N_B_LAYERS = DEPTH - N_A_LAYERS
POOL_WINDOWS = (2, 4, 8, 16)
N_POOL_GROUPS = len(POOL_WINDOWS)
POOL_GROUP = D_MODEL // N_POOL_GROUPS
N_HEADS = 8
HEAD_DIM = D_MODEL // (2 * N_HEADS)
V_HEAD_DIM = 2 * HEAD_DIM
ROT_DIM = HEAD_DIM // 4
ROPE_THETA = 500000.0
D_FF = 4 * D_MODEL
Q_BLOCK = 128
EPS = 1e-6

kernel_name = "yoco_pool_diffattn_encoder"


def rms_norm(x, g):
    xf = x.astype(jnp.float32)
    y = xf * lax.rsqrt(jnp.mean(xf * xf, axis=-1, keepdims=True) + EPS)
    return (y * g.astype(jnp.float32)).astype(x.dtype)


def rope_tables(seq):
    pos = jnp.arange(seq, dtype=jnp.float32)
    inv_freq = ROPE_THETA ** (-jnp.arange(0, ROT_DIM, 2, dtype=jnp.float32) / ROT_DIM)
    ang = pos[:, None] * inv_freq[None, :]
    return jnp.cos(ang), jnp.sin(ang)


def apply_partial_rope(t, cos, sin):
    half = ROT_DIM // 2
    r1 = t[..., :half]
    r2 = t[..., half:ROT_DIM]
    keep = t[..., ROT_DIM:]
    c = cos[None, :, None, None, :].astype(t.dtype)
    s = sin[None, :, None, None, :].astype(t.dtype)
    return jnp.concatenate([r1 * c - r2 * s, r2 * c + r1 * s, keep], axis=-1)


def multiscale_pool_mixer(h, w_pool, scale):
    b, s, d = h.shape
    hf = h.astype(jnp.float32)
    t = jnp.arange(1, s + 1, dtype=jnp.float32)
    groups = []
    for g, w in enumerate(POOL_WINDOWS):
        hg = hf[..., g * POOL_GROUP:(g + 1) * POOL_GROUP]
        cs = jnp.cumsum(hg, axis=1)
        lagged = jnp.pad(cs, ((0, 0), (w, 0), (0, 0)))[:, :s]
        cnt = jnp.minimum(t, float(w))[None, :, None]
        groups.append((cs - lagged) / cnt - hg)
    pooled = jnp.stack(groups, axis=2).astype(h.dtype)
    y = jnp.einsum('bsgc,gce->bsge', pooled, w_pool).reshape(b, s, d)
    return y * scale


def shared_kv(x, g, w_kv, cos, sin):
    b, s, _ = x.shape
    h = rms_norm(x, g)
    kv = h @ w_kv
    k = kv[..., :D_MODEL].reshape(b, s, N_HEADS, 2, HEAD_DIM)
    v = kv[..., D_MODEL:].reshape(b, s, N_HEADS, V_HEAD_DIM)
    return apply_partial_rope(k, cos, sin), v


def diff_attention(h, k, v, w_q, lam, subln_g, w_o, cos, sin, layer_idx):
    b, s, _ = h.shape
    q = (h @ w_q).reshape(b, s, N_HEADS, 2, HEAD_DIM)
    q = apply_partial_rope(q, cos, sin)
    lam_init = 0.8 - 0.6 * math.exp(-0.3 * layer_idx)
    lamf = lam.astype(jnp.float32)
    lam_full = (jnp.exp(jnp.sum(lamf[0] * lamf[1]))
                - jnp.exp(jnp.sum(lamf[2] * lamf[3])) + lam_init)
    sm_scale = HEAD_DIM ** -0.5
    chunk_k = jnp.arange(s) // CHUNK
    vf = v.astype(jnp.float32)
    neg = jnp.finfo(jnp.float32).min

    def block(i):
        q0 = i * Q_BLOCK
        qb = lax.dynamic_slice_in_dim(q, q0, Q_BLOCK, axis=1)
        sc = jnp.einsum('bqhcd,bkhcd->bhcqk', qb, k,
                        preferred_element_type=jnp.float32) * sm_scale
        chunk_q = (q0 + jnp.arange(Q_BLOCK)) // CHUNK
        visible = chunk_k[None, :] <= chunk_q[:, None]
        sc = jnp.where(visible, sc, neg)
        p = jax.nn.softmax(sc, axis=-1)
        a = p[:, :, 0] - lam_full * p[:, :, 1]
        return jnp.einsum('bhqk,bkhe->bqhe', a, vf)

    o = lax.map(block, jnp.arange(s // Q_BLOCK))
    o = jnp.moveaxis(o, 0, 1).reshape(b, s, N_HEADS, V_HEAD_DIM)
    o = rms_norm(o, subln_g) * (1.0 - lam_init)
    return o.reshape(b, s, D_MODEL).astype(h.dtype) @ w_o


def sqrelu_mlp(h, w_in, w_out):
    u = jax.nn.relu(h @ w_in)
    return (u * u) @ w_out


def setup_inputs(seed: int = 0) -> dict:
    key = jax.random.key(seed)
    ks = jax.random.split(key, 16)
    f32 = jnp.float32
    nrm = lambda k, shape: jax.random.normal(k, shape, f32)
    x = nrm(ks[0], (BATCH, SEQ, D_MODEL))
    mix_norm = 1.0 + 0.02 * nrm(ks[1], (DEPTH, D_MODEL))
    mlp_norm = 1.0 + 0.02 * nrm(ks[2], (DEPTH, D_MODEL))
    pool_w = nrm(ks[3], (N_A_LAYERS, N_POOL_GROUPS, POOL_GROUP, POOL_GROUP)) * POOL_GROUP ** -0.5
    pool_scale = 1.0 + 0.02 * nrm(ks[4], (N_A_LAYERS, D_MODEL))
    kv_norm = 1.0 + 0.02 * nrm(ks[5], (D_MODEL,))
    w_kv = nrm(ks[6], (D_MODEL, 2 * D_MODEL)) * D_MODEL ** -0.5
    w_q = nrm(ks[7], (N_B_LAYERS, D_MODEL, D_MODEL)) * D_MODEL ** -0.5
    lam = 0.1 * nrm(ks[8], (N_B_LAYERS, 4, HEAD_DIM))
    subln = 1.0 + 0.02 * nrm(ks[9], (N_B_LAYERS, V_HEAD_DIM))
    w_o = nrm(ks[10], (N_B_LAYERS, D_MODEL, D_MODEL)) * D_MODEL ** -0.5
    w_mlp_in = nrm(ks[11], (DEPTH, D_MODEL, D_FF)) * D_MODEL ** -0.5
    w_mlp_out = nrm(ks[12], (DEPTH, D_FF, D_MODEL)) * D_FF ** -0.5
    final_norm = 1.0 + 0.02 * nrm(ks[13], (D_MODEL,))
    return {"x": x, "mix_norm": mix_norm, "mlp_norm": mlp_norm, "pool_w": pool_w,
            "pool_scale": pool_scale, "kv_norm": kv_norm, "w_kv": w_kv, "w_q": w_q,
            "lam": lam, "subln": subln, "w_o": w_o, "w_mlp_in": w_mlp_in,
            "w_mlp_out": w_mlp_out, "final_norm": final_norm}


def reference(x, mix_norm, mlp_norm, pool_w, pool_scale, kv_norm, w_kv, w_q, lam, subln,
              w_o, w_mlp_in, w_mlp_out, final_norm):
    s = x.shape[1]
    cos, sin = rope_tables(s)
    h = x
    k = None
    v = None
    for l in range(DEPTH):
        if l < N_A_LAYERS:
            h = h + multiscale_pool_mixer(rms_norm(h, mix_norm[l]), pool_w[l], pool_scale[l])
        else:
            j = l - N_A_LAYERS
            h = h + diff_attention(rms_norm(h, mix_norm[l]), k, v, w_q[j], lam[j], subln[j],
                                   w_o[j], cos, sin, l)
        h = h + sqrelu_mlp(rms_norm(h, mlp_norm[l]), w_mlp_in[l], w_mlp_out[l])
        if l == N_A_LAYERS - 1:
            k, v = shared_kv(h, kv_norm, w_kv, cos, sin)
    return rms_norm(h, final_norm)
```

```cpp
#include <hip/hip_runtime.h>
#include <hip/hip_cooperative_groups.h>
#include <cstdio>
#include <cstdint>
namespace cg = cooperative_groups;

#ifndef MK_ONE_LAUNCH
#define MK_ONE_LAUNCH 1
#endif

#define LAS __attribute__((address_space(3)))
typedef unsigned short bf16_t;
typedef short bf16x8 __attribute__((ext_vector_type(8)));
typedef float f32x4 __attribute__((ext_vector_type(4)));
typedef float f32x16 __attribute__((ext_vector_type(16)));
typedef unsigned u32x4 __attribute__((ext_vector_type(4)));
typedef unsigned u32x2 __attribute__((ext_vector_type(2)));

constexpr int SEQ = 8192, DM = 2048, FF = 8192, NH = 8, HD = 128, VD = 256, PG = 512;
constexpr float EPS = 1e-6f;
constexpr size_t MiB = 1u << 20;
constexpr size_t WS_ROPE = 1 * MiB, WS_WPOOL = 2 * MiB, WS_WK = 8 * MiB, WS_WV = 16 * MiB, WS_WQ = 24 * MiB, WS_WO = 40 * MiB,
                 WS_WIN = 64 * MiB, WS_WOUT = 192 * MiB, WS_H = 320 * MiB, WS_XN = 384 * MiB, WS_XN2 = 416 * MiB, WS_U = 448 * MiB,
                 WS_K = 576 * MiB, WS_VT = 608 * MiB, WS_Q = 640 * MiB, WS_O = 672 * MiB, WS_END = 704 * MiB;
constexpr int LDS_BYTES = 147456;
constexpr int BAR_LDS_OFF = 147456 - 64, RL_LDS_OFF = 131072;
constexpr size_t WS_SSQ = 6 * MiB;
constexpr size_t WS_CTL = 0, CTL_BYTES = 16384;

__device__ __forceinline__ unsigned cvt_pk_bf16(float lo, float hi) { unsigned r; asm volatile("v_cvt_pk_bf16_f32 %0, %1, %2" : "=v"(r) : "v"(lo), "v"(hi)); return r; }
__device__ __forceinline__ f32x4 bf4_to_f32(u32x2 w) { f32x4 r; r.x = __uint_as_float(w.x << 16); r.y = __uint_as_float(w.x & 0xffff0000u); r.z = __uint_as_float(w.y << 16); r.w = __uint_as_float(w.y & 0xffff0000u); return r; }
template <bool F32> __device__ __forceinline__ f32x4 ld4(const void* base, size_t idx) { if (F32) return *(const f32x4*)((const float*)base + idx); return bf4_to_f32(*(const u32x2*)((const bf16_t*)base + idx)); }
__device__ __forceinline__ float wave_sum(float v) {
#pragma unroll
    for (int o = 1; o < 64; o <<= 1) v += __shfl_xor(v, o);
    return v;
}

namespace pg8 {
constexpr int BM = 256, BK = 64, HALF = 128, HTB = HALF * BK * 2, STAGE_BYTES = 8 * HTB, NXCD = 8, WGM = 8;
__host__ __device__ __forceinline__ int lds_byte(int r, int c) { const int st = (r >> 4) * 2 + (c >> 5), rr = r & 15, cc = c & 31, ob = rr * 64 + cc * 2; return st * 1024 + (ob ^ (((ob >> 9) & 1) << 5)); }
__host__ __device__ __forceinline__ void stage_rc(int b, int& R, int& C) { const int st = b / 1024, sb = b % 1024, swz = sb ^ (((sb >> 9) & 1) << 5); R = (st >> 1) * 16 + swz / 64; C = (st & 1) * 32 + (swz % 64) / 2; }
__host__ __device__ __forceinline__ int perm32(int rho) { const int n = rho >> 4, i = rho & 15; return 8 * (i >> 2) + 4 * n + (i & 3); }

struct Unit { int pm, pn; };
struct Gemm { const bf16_t* A; const bf16_t* Bt; int M, N, K, lda, ldb, grp; };

struct StaticOrder {
    int nM, nN, nwg, G, c;
    __host__ __device__ void init(int M, int N, int G_, int c_) { nM = M / BM; nN = N / BM; nwg = nM * nN; G = G_; c = c_; }
    __host__ __device__ bool next(int i, Unit& u) const {
        const long L = (long)i * G + c; if (L >= nwg) return false;
        int wgid = (int)L; { const int q = nwg / NXCD, r = nwg % NXCD, xcd = wgid % NXCD, off = wgid / NXCD; wgid = (xcd < r ? xcd * (q + 1) : r * (q + 1) + (xcd - r) * q) + off; }
        const int nig = WGM * nN, gid = wgid / nig, fm = gid * WGM, gsz = (nM - fm) < WGM ? (nM - fm) : WGM;
        u.pm = fm + ((wgid % nig) % gsz); u.pn = (wgid % nig) / gsz; return true;
    }
};

struct EpiBf16 {
    static constexpr bool PERM = true;
    __device__ __forceinline__ void init(f32x4 (&acc)[2][2][4][2], const Unit&, int, int, int, int) const {
#pragma unroll
        for (int a = 0; a < 2; ++a)
#pragma unroll
            for (int b = 0; b < 2; ++b)
#pragma unroll
                for (int m = 0; m < 4; ++m)
#pragma unroll
                    for (int n = 0; n < 2; ++n) acc[a][b][m][n] = (f32x4){0.f, 0.f, 0.f, 0.f};
    }
    bf16_t* O; int ldc; int act; const float* cosT; const float* sinT; float scale; const float* ssq; int colscale; LAS float* rl;
    __device__ __forceinline__ void operator()(const f32x4 (&acc)[2][2][4][2], const Unit& u, int wr, int wc, int fr, int fq) const {
        const int row0 = u.pm * BM + wr * 64 + fr, col0 = u.pn * BM + wc * 32 + 8 * fq;
        const bool rope = (cosT != nullptr) && (wc == 0);
        if (ssq) {
            if (wr == 0) { const int i = wc * 64 + fq * 16 + fr; const f32x4* sp = (const f32x4*)(ssq + (size_t)((colscale ? u.pn : u.pm) * BM + i) * 32);
                f32x4 t = sp[0];
#pragma unroll
                for (int k = 1; k < 8; ++k) t += sp[k];
                rl[i] = rsqrtf(((t.x + t.y) + (t.z + t.w)) * (1.f / DM) + EPS); }
            asm volatile("s_waitcnt lgkmcnt(0)" ::: "memory"); __builtin_amdgcn_s_barrier(); asm volatile("" ::: "memory");
        }
        f32x4 cs0[2], cs1[2];
#pragma unroll
        for (int bj = 0; bj < 2; ++bj) { cs0[bj] = (f32x4){scale, scale, scale, scale}; cs1[bj] = cs0[bj];
            if (ssq && colscale) { const LAS float* rp = rl + bj * HALF + wc * 32 + 8 * fq; cs0[bj] = *(const LAS f32x4*)rp * scale; cs1[bj] = *(const LAS f32x4*)(rp + 4) * scale; } }
#pragma unroll
        for (int ai = 0; ai < 2; ++ai)
#pragma unroll
            for (int m = 0; m < 4; ++m) { const int row = row0 + ai * HALF + m * 16; bf16_t* rowp = O + (size_t)row * ldc + col0;
                const float rs = (ssq && !colscale) ? rl[ai * HALF + wr * 64 + m * 16 + fr] : 1.f;
                f32x4 c0 = {1.f, 1.f, 1.f, 1.f}, c1 = c0, s0 = {0.f, 0.f, 0.f, 0.f}, s1 = s0;
                if (rope) { const float* cp = cosT + (size_t)row * 16 + 8 * (fq & 1); const float* sp = sinT + (size_t)row * 16 + 8 * (fq & 1);
                    c0 = *(const f32x4*)cp; c1 = *(const f32x4*)(cp + 4); s0 = *(const f32x4*)sp; s1 = *(const f32x4*)(sp + 4);
                    if (fq < 2) { s0 = -s0; s1 = -s1; } }
#pragma unroll
                for (int bj = 0; bj < 2; ++bj) { f32x4 v0 = acc[ai][bj][m][0] * rs, v1 = acc[ai][bj][m][1] * rs;
                    if (rope) {
#pragma unroll
                        for (int j = 0; j < 4; ++j) { const float p0 = __shfl_xor(v0[j], 32), p1 = __shfl_xor(v1[j], 32);
                            v0[j] = v0[j] * c0[j] + p0 * s0[j]; v1[j] = v1[j] * c1[j] + p1 * s1[j]; } }
                    v0 = v0 * cs0[bj]; v1 = v1 * cs1[bj];
                    if (act) {
#pragma unroll
                        for (int j = 0; j < 4; ++j) { const float a = fmaxf(v0[j], 0.f), b = fmaxf(v1[j], 0.f); v0[j] = a * a; v1[j] = b * b; } }
                    u32x4 w; w.x = cvt_pk_bf16(v0[0], v0[1]); w.y = cvt_pk_bf16(v0[2], v0[3]); w.z = cvt_pk_bf16(v1[0], v1[1]); w.w = cvt_pk_bf16(v1[2], v1[3]);
                    *(u32x4*)(rowp + bj * HALF) = w; }
                asm volatile("" ::: "memory"); }
    }
};
struct EpiRes {
    static constexpr bool PERM = false;
    const void* base; int base_f32; const float* cs; bf16_t* hb; float* ssq;
    __device__ __forceinline__ void init(f32x4 (&acc)[2][2][4][2], const Unit& u, int wr, int wc, int fr, int fq) const {
        const int col0 = u.pn * BM + wc * 32 + 4 * fq;
#pragma unroll
        for (int ai = 0; ai < 2; ++ai)
#pragma unroll
            for (int m = 0; m < 4; ++m) { const size_t off = (size_t)(u.pm * BM + ai * HALF + wr * 64 + m * 16 + fr) * DM + col0;
#pragma unroll
                for (int bj = 0; bj < 2; ++bj)
#pragma unroll
                    for (int n = 0; n < 2; ++n) { f32x4 bs = base_f32 ? ld4<true>(base, off + bj * HALF + n * 16) : ld4<false>(base, off + bj * HALF + n * 16);
                        if (cs) { const f32x4 c = *(const f32x4*)(cs + col0 + bj * HALF + n * 16); bs.x /= c.x; bs.y /= c.y; bs.z /= c.z; bs.w /= c.w; }
                        acc[ai][bj][m][n] = bs; } }
    }
    __device__ __forceinline__ void operator()(const f32x4 (&acc)[2][2][4][2], const Unit& u, int wr, int wc, int fr, int fq) const {
        const int col0 = u.pn * BM + wc * 32 + 4 * fq;
#pragma unroll
        for (int ai = 0; ai < 2; ++ai)
#pragma unroll
            for (int m = 0; m < 4; ++m) { const int row = u.pm * BM + ai * HALF + wr * 64 + m * 16 + fr; const size_t off = (size_t)row * DM + col0;
                float sq = 0.f;
#pragma unroll
                for (int bj = 0; bj < 2; ++bj)
#pragma unroll
                    for (int n = 0; n < 2; ++n) { const f32x4 csv = cs ? *(const f32x4*)(cs + col0 + bj * HALF + n * 16) : (f32x4){1.f, 1.f, 1.f, 1.f};
                        const f32x4 v = acc[ai][bj][m][n] * csv;
                        sq += (v.x * v.x + v.y * v.y) + (v.z * v.z + v.w * v.w);
                        u32x2 w; w.x = cvt_pk_bf16(v.x, v.y); w.y = cvt_pk_bf16(v.z, v.w); *(u32x2*)(hb + off + bj * HALF + n * 16) = w; }
                sq += __shfl_xor(sq, 16); sq += __shfl_xor(sq, 32);
                if (fq == 0) ssq[(size_t)row * 32 + u.pn * 4 + wc] = sq; }
    }
};

template <class Epi>
__device__ __forceinline__ void gemm_phase(const int tid, LAS unsigned char* lds, const Gemm g, const StaticOrder& S, const Epi& E) {
    const int wid = __builtin_amdgcn_readfirstlane(tid >> 6), lane = tid & 63, wr = wid >> 2, wc = wid & 3, fr = lane & 15, fq = lane >> 4;
    const int K = g.K, nt = K / BK;
    unsigned voffA[2], voffB[2];
#pragma unroll
    for (int i = 0; i < 2; ++i) { int R, C; stage_rc(tid * 16 + i * 8192, R, C); const int Rb = Epi::PERM ? ((R & ~31) + perm32(R & 31)) : R;
        voffA[i] = (unsigned)(R * g.lda + C) * 2u; voffB[i] = (unsigned)(Rb * g.ldb + C) * 2u; }
    const size_t kstep = (size_t)(BK * 2);
    const size_t hstepA = (size_t)HALF * g.lda * 2, hstepB = (size_t)HALF * g.ldb * 2;
    const size_t tstepA = 2 * hstepA, tstepB = 2 * hstepB;
    const unsigned ldsw = (unsigned)wid * 1024u;
    const int aoff = lds_byte(wr * 64 + fr, fq * 8), boff = lds_byte(wc * 32 + fr, fq * 8);
#define PG8_SA(b, h) (((b) * 2 + (h)) * HTB)
#define PG8_SB(b, h) ((4 + (b) * 2 + (h)) * HTB)
#define PG8_STAGE(bufoff, gbase, voff) do { _Pragma("unroll") for (int _i = 0; _i < 2; ++_i) \
        __builtin_amdgcn_global_load_lds((const unsigned*)((const char*)(gbase) + (voff)[_i]), (LAS unsigned*)(lds + (bufoff) + ldsw + _i * 8192), 16, 0, 0); } while (0)
#define PG8_LDA(dst, b, h) do { _Pragma("unroll") for (int m = 0; m < 4; ++m) _Pragma("unroll") for (int k = 0; k < 2; ++k) dst[m][k] = *(const LAS bf16x8*)(lds + PG8_SA(b, h) + aoff + m * 2048 + k * 1024); } while (0)
#define PG8_LDB(dst, b, h) do { _Pragma("unroll") for (int n = 0; n < 2; ++n) _Pragma("unroll") for (int k = 0; k < 2; ++k) dst[n][k] = *(const LAS bf16x8*)(lds + PG8_SB(b, h) + boff + n * 2048 + k * 1024); } while (0)
#define PG8_MMA(ai, bj, At, Bt) do { __builtin_amdgcn_s_setprio(1); _Pragma("unroll") for (int m = 0; m < 4; ++m) _Pragma("unroll") for (int n = 0; n < 2; ++n) _Pragma("unroll") for (int k = 0; k < 2; ++k) \
        acc[ai][bj][m][n] = __builtin_amdgcn_mfma_f32_16x16x32_bf16(Bt[n][k], At[m][k], acc[ai][bj][m][n], 0, 0, 0); __builtin_amdgcn_s_setprio(0); } while (0)
#define PG8_WAIT_V(n) asm volatile("s_waitcnt vmcnt(" #n ")" ::: "memory")
#define PG8_WAIT_L(n) asm volatile("s_waitcnt lgkmcnt(" #n ")" ::: "memory")
#define PG8_BAR __builtin_amdgcn_s_barrier()
#define PG8_SCHED __builtin_amdgcn_sched_barrier(0)
#define PG8_ABASE(u) ((const char*)g.A + (size_t)(u).pm * tstepA + (g.grp ? (size_t)((u).pn / g.grp) * K * 2 : (size_t)0))
#define PG8_BBASE(u) ((const char*)g.Bt + (size_t)(u).pn * tstepB)
    Unit cur, nxt; int ui = 0;
    if (!S.next(0, cur)) return;
    f32x4 acc[2][2][4][2];
    E.init(acc, cur, wr, wc, fr, fq);
    bf16x8 At[4][2], B0[2][2], B1[2][2];
    const char* cA = PG8_ABASE(cur); const char* cB = PG8_BBASE(cur);
    PG8_STAGE(PG8_SB(0, 0), cB, voffB); PG8_STAGE(PG8_SB(0, 1), cB + hstepB, voffB); PG8_STAGE(PG8_SA(0, 0), cA, voffA); PG8_STAGE(PG8_SA(0, 1), cA + hstepA, voffA);
    if (wr == 1) PG8_BAR;
    PG8_WAIT_V(2); PG8_BAR;
    PG8_STAGE(PG8_SB(1, 0), cB + kstep, voffB); PG8_STAGE(PG8_SA(1, 0), cA + kstep, voffA); PG8_STAGE(PG8_SB(1, 1), cB + hstepB + kstep, voffB);
    PG8_WAIT_V(6); PG8_BAR;
    for (;;) {
        const bool has_next = S.next(ui + 1, nxt);
        const char* nA = has_next ? PG8_ABASE(nxt) : cA; const char* nB = has_next ? PG8_BBASE(nxt) : cB;
        for (int t = 0; t < nt; t += 2) {
            const bool last = (t == nt - 2);
            const char* a1 = cA + (size_t)(t + 1) * kstep;
            const char* a2 = last ? nA : cA + (size_t)(t + 2) * kstep; const char* b2 = last ? nB : cB + (size_t)(t + 2) * kstep;
            const char* a3 = a2 + kstep; const char* b3 = b2 + kstep;
            PG8_LDB(B0, 0, 0); PG8_LDB(B1, 0, 1); PG8_SCHED; PG8_LDA(At, 0, 0); PG8_STAGE(PG8_SA(1, 1), a1 + hstepA, voffA);
            PG8_WAIT_V(8); PG8_WAIT_L(0); PG8_BAR; PG8_MMA(0, 0, At, B0); PG8_MMA(0, 1, At, B1); PG8_BAR; PG8_SCHED;
            PG8_LDA(At, 0, 1); PG8_STAGE(PG8_SB(0, 0), b2, voffB); PG8_STAGE(PG8_SB(0, 1), b2 + hstepB, voffB); PG8_STAGE(PG8_SA(0, 0), a2, voffA);
            PG8_WAIT_V(8); PG8_WAIT_L(0); PG8_BAR; PG8_MMA(1, 0, At, B0); PG8_MMA(1, 1, At, B1); PG8_BAR; PG8_SCHED;
            PG8_LDB(B0, 1, 0); PG8_LDB(B1, 1, 1); PG8_SCHED; PG8_LDA(At, 1, 0); PG8_STAGE(PG8_SA(0, 1), a2 + hstepA, voffA);
            PG8_WAIT_V(8); PG8_WAIT_L(0); PG8_BAR; PG8_MMA(0, 0, At, B0); PG8_MMA(0, 1, At, B1); PG8_BAR; PG8_SCHED;
            PG8_LDA(At, 1, 1); PG8_STAGE(PG8_SB(1, 0), b3, voffB); PG8_STAGE(PG8_SB(1, 1), b3 + hstepB, voffB); PG8_STAGE(PG8_SA(1, 0), a3, voffA);
            PG8_WAIT_V(8); PG8_WAIT_L(0); PG8_BAR; PG8_MMA(1, 0, At, B0); PG8_MMA(1, 1, At, B1); PG8_BAR; PG8_SCHED;
        }
        if (wr == 0) PG8_BAR;
        { int fr2 = fr, fq2 = fq; asm volatile("" : "+v"(fr2), "+v"(fq2)); E(acc, cur, wr, wc, fr2, fq2); }
        if (!has_next) break;
        cur = nxt; cA = nA; cB = nB; ++ui;
        E.init(acc, cur, wr, wc, fr, fq);
        if (wr == 1) PG8_BAR;
    }
    PG8_WAIT_V(0);
    PG8_BAR;
#undef PG8_SA
#undef PG8_SB
#undef PG8_STAGE
#undef PG8_LDA
#undef PG8_LDB
#undef PG8_MMA
#undef PG8_WAIT_V
#undef PG8_WAIT_L
#undef PG8_BAR
#undef PG8_SCHED
#undef PG8_ABASE
#undef PG8_BBASE
}
}

namespace att {
constexpr int KT = 32768, STG = 65536, WSOFF = 131072;
__device__ __forceinline__ int crow(int r, int hi) { return (r & 3) + 8 * (r >> 2) + 4 * hi; }
struct Params { const bf16_t* Q; const bf16_t* K; const bf16_t* VT; bf16_t* O; const float* subln; float lam_full, out_scale; };

__device__ __forceinline__ void unit(const int wid, LAS unsigned char* lds, const Params& P, int h, int qb) {
    int lane; asm volatile("v_mbcnt_lo_u32_b32 %0, -1, 0\n\tv_mbcnt_hi_u32_b32 %0, -1, %0" : "=v"(lane));
    const int r32 = lane & 31, hi = lane >> 5;
    const int c = wid >> 2, rb = wid & 3, q0 = qb * 128, cq = 2 * qb + (rb >> 1), NT = 2 * qb + 2;
    LAS float* wsf = (LAS float*)(lds + WSOFF) + wid * 64;
    unsigned koff0, voff0;
    { const int row = 4 * wid + (lane >> 4), ch = (lane & 15) ^ (row & 15);
      koff0 = (unsigned)((row * DM + (h * 2) * HD + ch * 8) * 2);
      const int e = 8 * wid + (lane >> 3), cv = (lane & 7) ^ ((e >> 1) & 7);
      voff0 = (unsigned)(((h * VD + e) * SEQ + cv * 8) * 2); }
    const char* Kc = (const char*)P.K; const char* Vc = (const char*)P.VT;
#define ATT_ISSUE(t, st) do { _Pragma("unroll") for (int _i = 0; _i < 4; ++_i) { \
        __builtin_amdgcn_global_load_lds((const unsigned*)(Kc + ((size_t)(t) * (64 * DM * 2) + (size_t)((_i & 1) * 32 * DM * 2 + (_i >> 1) * HD * 2)) + koff0), (LAS unsigned*)(lds + (st) * STG + (_i * 8 + wid) * 1024), 16, 0, 0); \
        __builtin_amdgcn_global_load_lds((const unsigned*)(Vc + ((size_t)(t) * 128 + (size_t)_i * (64 * SEQ * 2)) + voff0), (LAS unsigned*)(lds + (st) * STG + KT + (_i * 8 + wid) * 1024), 16, 0, 0); } } while (0)
    ATT_ISSUE(0, 0);
    bf16x8 qr[8];
    { const bf16_t* Qw = P.Q + (size_t)(q0 + 32 * rb + r32) * DM + (h * 2 + c) * HD + hi * 8;
#pragma unroll
      for (int d0 = 0; d0 < 8; ++d0) qr[d0] = *(const bf16x8*)(Qw + d0 * 16); }
    float m_reg = -1e30f, l_reg = 0.f;
    f32x16 o[8];
#pragma unroll
    for (int nb = 0; nb < 8; ++nb)
#pragma unroll
        for (int r = 0; r < 16; ++r) o[nb][r] = 0.f;
    const int ky = (hi ^ (r32 & 15));
    const unsigned kbase = (unsigned)(c * 16384 + r32 * 256);
    const int vsw = hi ^ ((r32 >> 1) & 7);
    const unsigned vbase = (unsigned)(KT + r32 * 128);
    for (int t = 0; t < NT; ++t) {
        asm volatile("s_waitcnt vmcnt(0)" ::: "memory");
        __syncthreads();
        if (t + 1 < NT) ATT_ISSUE(t + 1, (t + 1) & 1);
        if (t <= cq) {
            LAS unsigned char* st = lds + (t & 1) * STG;
            f32x16 p0, p1;
#pragma unroll
            for (int r = 0; r < 16; ++r) { p0[r] = 0.f; p1[r] = 0.f; }
            {
                bf16x8 ka[8];
#define ATT_KRD(d0, hf) (*(const LAS bf16x8*)(st + kbase + (unsigned)(((2 * (d0)) ^ ky) << 4) + (hf) * 8192))
#pragma unroll
                for (int i = 0; i < 4; ++i) { ka[2 * i] = ATT_KRD(i, 0); ka[2 * i + 1] = ATT_KRD(i, 1); }
                __builtin_amdgcn_sched_barrier(0);
#pragma unroll
                for (int i = 0; i < 4; ++i) {
                    p0 = __builtin_amdgcn_mfma_f32_32x32x16_bf16(ka[2 * i], qr[i], p0, 0, 0, 0);
                    p1 = __builtin_amdgcn_mfma_f32_32x32x16_bf16(ka[2 * i + 1], qr[i], p1, 0, 0, 0);
                    ka[2 * i] = ATT_KRD(4 + i, 0); ka[2 * i + 1] = ATT_KRD(4 + i, 1);
                    __builtin_amdgcn_sched_barrier(0);
                }
#pragma unroll
                for (int i = 0; i < 4; ++i) {
                    p0 = __builtin_amdgcn_mfma_f32_32x32x16_bf16(ka[2 * i], qr[4 + i], p0, 0, 0, 0);
                    p1 = __builtin_amdgcn_mfma_f32_32x32x16_bf16(ka[2 * i + 1], qr[4 + i], p1, 0, 0, 0);
                    __builtin_amdgcn_sched_barrier(0);
                }
#undef ATT_KRD
            }
            __builtin_amdgcn_sched_barrier(0);
            float pmax = p0[0];
#pragma unroll
            for (int r = 1; r < 16; ++r) pmax = fmaxf(pmax, p0[r]);
#pragma unroll
            for (int r = 0; r < 16; ++r) pmax = fmaxf(pmax, p1[r]);
            { auto rr = __builtin_amdgcn_permlane32_swap(__float_as_uint(pmax), __float_as_uint(pmax), false, false);
              pmax = fmaxf(__uint_as_float(rr[0]), __uint_as_float(rr[1])); }
            const bool grow = __any(pmax - m_reg > 8.f);
            float alpha = 1.f;
            if (grow) { const float mnew = fmaxf(m_reg, pmax); alpha = __builtin_amdgcn_exp2f(m_reg - mnew); m_reg = mnew; }
            const float mn = m_reg;
#pragma unroll
            for (int r = 0; r < 16; ++r) { p0[r] = __builtin_amdgcn_exp2f(p0[r] - mn); p1[r] = __builtin_amdgcn_exp2f(p1[r] - mn); }
            float ps = 0.f;
#pragma unroll
            for (int r = 0; r < 16; ++r) ps += p0[r] + p1[r];
            { auto rr = __builtin_amdgcn_permlane32_swap(__float_as_uint(ps), __float_as_uint(ps), false, false);
              ps = __uint_as_float(rr[0]) + __uint_as_float(rr[1]); }
            l_reg = l_reg * alpha + ps;
            if (grow) {
                if (hi == 0) wsf[r32] = alpha;
                asm volatile("s_waitcnt lgkmcnt(0)" ::: "memory");
#pragma unroll
                for (int r = 0; r < 16; ++r) { const float al = wsf[crow(r, hi)];
#pragma unroll
                    for (int nb = 0; nb < 8; ++nb) o[nb][r] *= al; }
            }
            __builtin_amdgcn_sched_barrier(0);
            bf16x8 pa[4];
#define ATT_PK4(Pv, BASE, OUT) do { const unsigned a0 = cvt_pk_bf16(Pv[BASE + 0], Pv[BASE + 1]), a1 = cvt_pk_bf16(Pv[BASE + 2], Pv[BASE + 3]); \
            const unsigned b0 = cvt_pk_bf16(Pv[BASE + 4], Pv[BASE + 5]), b1 = cvt_pk_bf16(Pv[BASE + 6], Pv[BASE + 7]); \
            auto r0 = __builtin_amdgcn_permlane32_swap(a0, b0, false, false); auto r1 = __builtin_amdgcn_permlane32_swap(a1, b1, false, false); \
            u32x4 w = {r0[0], r1[0], r0[1], r1[1]}; OUT = __builtin_bit_cast(bf16x8, w); } while (0)
            ATT_PK4(p0, 0, pa[0]); ATT_PK4(p0, 8, pa[1]); ATT_PK4(p1, 0, pa[2]); ATT_PK4(p1, 8, pa[3]);
#undef ATT_PK4
            {
                bf16x8 vf[8];
                __builtin_amdgcn_s_setprio(1);
#define ATT_VRD(s_, nb) (*(const LAS bf16x8*)(st + vbase + (unsigned)(((2 * (s_)) ^ vsw) << 4) + (nb) * 4096))
#pragma unroll
                for (int nb = 0; nb < 8; ++nb) vf[nb] = ATT_VRD(0, nb);
                __builtin_amdgcn_sched_barrier(0);
#pragma unroll
                for (int s = 0; s < 4; ++s) {
#pragma unroll
                    for (int nb = 0; nb < 8; ++nb) {
                        o[nb] = __builtin_amdgcn_mfma_f32_32x32x16_bf16(pa[s], vf[nb], o[nb], 0, 0, 0);
                        if (s < 3) vf[nb] = ATT_VRD(s + 1, nb);
                        if (nb & 1) __builtin_amdgcn_sched_barrier(0);
                    }
                }
#undef ATT_VRD
                __builtin_amdgcn_s_setprio(0);
            }
        }
    }
#undef ATT_ISSUE
    if (hi == 0) wsf[r32] = l_reg;
    asm volatile("s_waitcnt lgkmcnt(0)" ::: "memory");
    int lane2 = lane; asm volatile("" : "+v"(lane2));
    const int r32e = lane2 & 31, hie = lane2 >> 5;
    __syncthreads();
    LAS float* X = (LAS float*)lds + rb * 8192 + lane2;
    if (c == 1) {
#pragma unroll
        for (int r = 0; r < 16; ++r) { const float rl = P.lam_full / wsf[crow(r, hie)];
#pragma unroll
            for (int nb = 0; nb < 8; ++nb) X[(nb * 16 + r) * 64] = o[nb][r] * rl;
            if ((r & 3) == 3) __builtin_amdgcn_sched_barrier(0); }
    }
    __syncthreads();
    if (c == 0) {
        bf16_t* Ob = P.O + (size_t)(q0 + 32 * rb + 4 * hie) * DM + h * VD + r32e;
        float gsub[8];
#pragma unroll
        for (int nb = 0; nb < 8; ++nb) gsub[nb] = P.subln[nb * 32 + r32e] * P.out_scale;
#pragma unroll
        for (int r = 0; r < 16; ++r) { const float rl = 1.f / wsf[crow(r, hie)];
            float v[8], sq = 0.f;
#pragma unroll
            for (int nb = 0; nb < 8; ++nb) { v[nb] = o[nb][r] * rl - X[(nb * 16 + r) * 64]; sq += v[nb] * v[nb]; }
#define ATT_SWZ(v, x) __builtin_bit_cast(float, __builtin_amdgcn_ds_swizzle(__builtin_bit_cast(int, (v)), 0x1f | ((x) << 10)))
            sq += ATT_SWZ(sq, 1); sq += ATT_SWZ(sq, 2); sq += ATT_SWZ(sq, 4); sq += ATT_SWZ(sq, 8); sq += ATT_SWZ(sq, 16);
#undef ATT_SWZ
            const float sc = rsqrtf(sq * (1.f / VD) + EPS);
#pragma unroll
            for (int nb = 0; nb < 8; ++nb) { const unsigned w = cvt_pk_bf16(v[nb] * sc * gsub[nb], 0.f); Ob[(size_t)((r & 3) + 8 * (r >> 2)) * DM + nb * 32] = (bf16_t)(w & 0xffffu); }
            __builtin_amdgcn_sched_barrier(0); }
    }
    __syncthreads();
}
}

enum { T_PRO = 0, T_GEMM_RES = 1, T_GEMM_BF16 = 2, T_NORM = 3, T_POOL = 4, T_ATT = 5, T_COMB = 6 };
struct PhaseDesc { const void* p0; const void* p1; void* p2; const void* p3; const void* p4; void* p5; void* p6; int type, M, N, K, lda, ldb, grp, ldc, flag, sync; float f0, f1; };
constexpr int MAX_PH = 30;
struct Args { const float* in[14]; float* out; unsigned char* ws; int ph_lo, ph_hi; PhaseDesc d[MAX_PH]; };

__device__ __forceinline__ void transpose_item(const float* W, int ldw, bf16_t* WT, int ldt, LAS unsigned* scr, int k0, int n0, int lane, const float* g) {
    const int q = lane >> 4, c4 = (lane & 15) * 4;
    const float* src = W + (size_t)(k0 + 2 * q) * ldw + n0 + c4;
    f32x4 a[8], b[8];
#pragma unroll
    for (int i2 = 0; i2 < 8; ++i2) { a[i2] = *(const f32x4*)(src + (size_t)(8 * i2) * ldw); b[i2] = *(const f32x4*)(src + (size_t)(8 * i2 + 1) * ldw); }
    if (g) {
#pragma unroll
        for (int i2 = 0; i2 < 8; ++i2) { const float ga = g[k0 + 8 * i2 + 2 * q], gb = g[k0 + 8 * i2 + 2 * q + 1]; a[i2] = a[i2] * ga; b[i2] = b[i2] * gb; }
    }
#pragma unroll
    for (int i2 = 0; i2 < 8; ++i2) { LAS unsigned* d = scr + c4 * 33 + 4 * i2 + q;
        d[0 * 33] = cvt_pk_bf16(a[i2].x, b[i2].x); d[1 * 33] = cvt_pk_bf16(a[i2].y, b[i2].y); d[2 * 33] = cvt_pk_bf16(a[i2].z, b[i2].z); d[3 * 33] = cvt_pk_bf16(a[i2].w, b[i2].w); }
    asm volatile("s_waitcnt lgkmcnt(0)" ::: "memory");
    const int c8 = lane & 7;
#pragma unroll
    for (int i = 0; i < 8; ++i) { const int n = (lane >> 3) + 8 * i; const LAS unsigned* sp = scr + n * 33 + 4 * c8;
        u32x4 o; o.x = sp[0]; o.y = sp[1]; o.z = sp[2]; o.w = sp[3];
        *(u32x4*)(WT + (size_t)(n0 + n) * ldt + k0 + 8 * c8) = o; }
    asm volatile("s_waitcnt lgkmcnt(0)" ::: "memory");
}
__device__ __forceinline__ void transpose_matrix_items(const float* src, int ldw, int K, int N, bf16_t* dst, LAS unsigned* scr, int item, int lane, const float* g) {
    const int nblk = N / 64, kb = item / nblk, nb = item % nblk;
    transpose_item(src, ldw, dst, K, scr, 64 * kb, 64 * nb, lane, g);
}

__device__ __forceinline__ void norm_row(const bf16_t* xrow, const float* g1, float* of, int lane) {
    f32x4 v[8]; float s = 0.f;
#pragma unroll
    for (int j = 0; j < 8; ++j) { v[j] = ld4<false>(xrow, (size_t)(lane + 64 * j) * 4); s += (v[j].x * v[j].x + v[j].y * v[j].y) + (v[j].z * v[j].z + v[j].w * v[j].w); }
    const float rstd = rsqrtf(wave_sum(s) * (1.f / DM) + EPS);
#pragma unroll
    for (int j = 0; j < 8; ++j) { const f32x4 ga = *((const f32x4*)g1 + lane + 64 * j); *((f32x4*)of + lane + 64 * j) = v[j] * rstd * ga; }
}
__device__ __forceinline__ void norm_phase(const bf16_t* H, const float* g1, float* of, int gw, int ngw, int lane) {
    for (int m = gw; m < SEQ; m += ngw) norm_row(H + (size_t)m * DM, g1, of + (size_t)m * DM, lane);
}

__device__ __forceinline__ void combine_phase(const _Float16* OD, const float* subln, bf16_t* OB, float lam_full, float out_scale, int gw, int ngw, int lane) {
    typedef _Float16 h4 __attribute__((ext_vector_type(4)));
    const f32x4 gs = *((const f32x4*)subln + lane);
    for (int m = gw; m < SEQ; m += ngw) {
        const h4* a = (const h4*)(OD + (size_t)m * DM) + lane; const h4* b = (const h4*)(OD + (size_t)SEQ * DM + (size_t)m * DM) + lane;
        u32x2* o = (u32x2*)(OB + (size_t)m * DM) + lane;
#pragma unroll
        for (int hd = 0; hd < NH; ++hd) {
            const h4 x = a[64 * hd], y = b[64 * hd];
            f32x4 v; v.x = (float)x.x - lam_full * (float)y.x; v.y = (float)x.y - lam_full * (float)y.y; v.z = (float)x.z - lam_full * (float)y.z; v.w = (float)x.w - lam_full * (float)y.w;
            const float ss = wave_sum((v.x * v.x + v.y * v.y) + (v.z * v.z + v.w * v.w));
            const float sc = rsqrtf(ss * (1.f / VD) + EPS) * out_scale;
            const f32x4 z = v * sc * gs;
            u32x2 w; w.x = cvt_pk_bf16(z.x, z.y); w.y = cvt_pk_bf16(z.z, z.w); o[64 * hd] = w;
        }
    }
}

template <int W, bool F32>
__device__ __forceinline__ void pool_cols(const void* H, const f32x4 g, const LAS float* rstd, int t0, bf16_t* PB, int c4) {
    f32x4 ring[W];
#pragma unroll
    for (int k = 0; k < W - 1; ++k) { const int t = t0 - (W - 1) + k;
        ring[k] = (t >= 0) ? ld4<F32>(H, (size_t)t * DM + c4) * (rstd[t - (t0 - 15)] ) * g : (f32x4){0.f, 0.f, 0.f, 0.f}; }
    for (int tt = 0; tt < 32; tt += W) {
#pragma unroll
        for (int u = 0; u < W; ++u) { const int t = t0 + tt + u;
            const f32x4 cur = ld4<F32>(H, (size_t)t * DM + c4) * rstd[t - (t0 - 15)] * g;
            ring[(W - 1 + u) % W] = cur;
            f32x4 sum = ring[0];
#pragma unroll
            for (int k = 1; k < W; ++k) sum += ring[k];
            const float inv = 1.f / (float)((t + 1) < W ? (t + 1) : W);
            const f32x4 y = sum * inv - cur;
            u32x2 w; w.x = cvt_pk_bf16(y.x, y.y); w.y = cvt_pk_bf16(y.z, y.w);
            *(u32x2*)(PB + (size_t)t * DM + c4) = w; }
    }
}
template <bool F32>
__device__ __forceinline__ void pool_phase(const int tid, LAS unsigned char* lds, const void* H, const float* g, bf16_t* PB, int vcu, int G) {
    const int lane = tid & 63, wid = tid >> 6;
    LAS float* rstd = (LAS float*)lds;
    for (int item = vcu; item < SEQ / 32; item += G) {
        const int t0 = item * 32;
        __syncthreads();
        for (int i = wid; i < 47; i += 8) { const int t = t0 - 15 + i;
            float r = 0.f;
            if (t >= 0) { float s = 0.f;
#pragma unroll
                for (int j = 0; j < 8; ++j) { const f32x4 v = ld4<F32>(H, (size_t)t * DM + (size_t)(lane + 64 * j) * 4); s += (v.x * v.x + v.y * v.y) + (v.z * v.z + v.w * v.w); }
                r = rsqrtf(wave_sum(s) * (1.f / DM) + EPS); }
            if (lane == 0) rstd[i] = r; }
        __syncthreads();
        const int c4 = tid * 4; const f32x4 gv = *(const f32x4*)(g + c4); const int grp = tid >> 7;
        if (grp == 0) pool_cols<2, F32>(H, gv, rstd, t0, PB, c4);
        else if (grp == 1) pool_cols<4, F32>(H, gv, rstd, t0, PB, c4);
        else if (grp == 2) pool_cols<8, F32>(H, gv, rstd, t0, PB, c4);
        else pool_cols<16, F32>(H, gv, rstd, t0, PB, c4);
    }
}

typedef __attribute__((address_space(1))) unsigned gu32;
#define XB_TMO      128
#define XB_XCNT(j)  (256  + 64 * (j))
#define XB_XSUB(j)  (1280 + 64 * (j))
#define XB_XGEN(j)  (2304 + 64 * (j))
#define XB_TOP      3328
#define XB_TOPGEN   3392
#define XCD_BAR_WORDS 3456
#define XB_SPIN_CAP (1u << 18)

__device__ __forceinline__ unsigned xb_ld(unsigned* p)              { return __hip_atomic_load(p, __ATOMIC_RELAXED, __HIP_MEMORY_SCOPE_AGENT); }
__device__ __forceinline__ unsigned xb_add(unsigned* p, unsigned v) { return __hip_atomic_fetch_add(p, v, __ATOMIC_RELAXED, __HIP_MEMORY_SCOPE_AGENT); }
__device__ __forceinline__ unsigned xb_xcc_id() { return (unsigned)__builtin_amdgcn_s_getreg((3 << 11) | 20) & 0xFu; }
#define XB_SPIN(cond, bar) do { unsigned _sp = 0; while (cond) { __builtin_amdgcn_s_sleep(1); \
    if ((++_sp & 255u) == 0u) { if (xb_ld(&(bar)[XB_TMO])) break; if (_sp > XB_SPIN_CAP) { atomicAdd(&(bar)[XB_TMO], 1u); break; } } } } while (0)

struct XcdBarrier {
    unsigned* bar; unsigned x; int wave;
    volatile LAS unsigned* st;
};

__device__ __forceinline__ XcdBarrier xcd_barrier_post(unsigned* bar, volatile LAS unsigned* st) {
    XcdBarrier b; b.bar = bar; b.x = xb_xcc_id(); b.st = st;
    if (threadIdx.x == 0) (void)xb_add(&bar[XB_XCNT(b.x)], 1u);
    return b;
}
__device__ __forceinline__ void xcd_barrier_complete(unsigned* bar, unsigned x, unsigned& nloc, unsigned& nx) {
    const unsigned G = gridDim.x * gridDim.y * gridDim.z;
    unsigned sum, cnt, mine, sp = 0u;
    for (;;) {
        sum = 0u; cnt = 0u; mine = 0u;
#pragma unroll
        for (unsigned j = 0; j < 16; ++j) { const unsigned c = xb_ld(&bar[XB_XCNT(j)]); sum += c; cnt += (c > 0u) ? 1u : 0u; mine = (j == x) ? c : mine; }
        if (sum == G) break;
        __builtin_amdgcn_s_sleep(1);
        if ((++sp & 255u) == 0u) { if (xb_ld(&bar[XB_TMO])) break; if (sp > XB_SPIN_CAP) { atomicAdd(&bar[XB_TMO], 1u); break; } }
    }
    nloc = mine > 0u ? mine : 1u; nx = cnt > 0u ? cnt : 1u;
}

__device__ __forceinline__ void xcd_barrier(const XcdBarrier& b) {
    asm volatile("s_waitcnt vmcnt(0)" ::: "memory");
    __syncthreads();
    int l0_; asm volatile("v_mbcnt_lo_u32_b32 %0, -1, 0\n\tv_mbcnt_hi_u32_b32 %0, -1, %0" : "=v"(l0_));
    if (b.wave == 0 && l0_ == 0) {
        unsigned* bar = b.bar;
        __builtin_amdgcn_s_waitcnt(0);
        unsigned nloc = b.st[0], nx = b.st[1];
        if (nloc == 0u) { xcd_barrier_complete(bar, b.x, nloc, nx); b.st[0] = nloc; b.st[1] = nx; }
        const unsigned old = xb_add(&bar[XB_XSUB(b.x)], 1u);
        const unsigned gen = old / nloc;
        if (old + 1u == (gen + 1u) * nloc) {
            __builtin_amdgcn_fence(__ATOMIC_RELEASE, "agent");
            asm volatile("s_waitcnt vmcnt(0)" ::: "memory");
            const unsigned og = xb_add(&bar[XB_TOP], 1u);
            const unsigned tg = og / nx;
            if (og + 1u == (tg + 1u) * nx) xb_add(&bar[XB_TOPGEN], 1u);
            else XB_SPIN(xb_ld(&bar[XB_TOPGEN]) == tg, bar);
            __builtin_amdgcn_fence(__ATOMIC_ACQUIRE, "agent");
            xb_add(&bar[XB_XGEN(b.x)], 1u);
            asm volatile("s_waitcnt vmcnt(0)" ::: "memory");
        } else {
            XB_SPIN(xb_ld(&bar[XB_XGEN(b.x)]) == gen, bar);
            __builtin_amdgcn_fence(__ATOMIC_ACQUIRE, "agent");
            asm volatile("s_waitcnt vmcnt(0)" ::: "memory");
        }
    }
    __syncthreads();
}

__global__ void __launch_bounds__(512, 2) fwd(Args args) {
    extern __shared__ __attribute__((aligned(16))) unsigned char lds_raw[];
    LAS unsigned char* lds = (LAS unsigned char*)lds_raw;
    const int G = gridDim.x, bx = blockIdx.x, vcu = (G % 8 == 0) ? (bx % 8) * (G / 8) + bx / 8 : bx;
    cg::grid_group grid = cg::this_grid();
    const int wave = __builtin_amdgcn_readfirstlane((int)threadIdx.x >> 6);
    volatile LAS unsigned* bst = (volatile LAS unsigned*)(lds + BAR_LDS_OFF);
    if (threadIdx.x < 16) bst[threadIdx.x] = 0u;
    __syncthreads();
    XcdBarrier bar = xcd_barrier_post((unsigned*)(args.ws + WS_CTL), bst); bar.wave = wave;
    if (args.ph_lo < 0) grid.sync();
    for (int ph = args.ph_lo; ph < args.ph_hi; ++ph) {
        const int gw = vcu * 8 + wave, ngw = G * 8;
#define GET_LANE_TID() int lane; asm volatile("v_mbcnt_lo_u32_b32 %0, -1, 0\n\tv_mbcnt_hi_u32_b32 %0, -1, %0" : "=v"(lane)); const int tid = wave * 64 + lane; (void)tid
        const PhaseDesc& d = args.d[ph];
        const int type = d.type;
        if (type == T_GEMM_RES) {
            GET_LANE_TID();
            pg8::Gemm g{(const bf16_t*)d.p0, (const bf16_t*)d.p1, d.M, d.N, d.K, d.lda, d.ldb, d.grp}; pg8::StaticOrder S; S.init(d.M, d.N, G, bx);
            pg8::EpiRes E{d.p3, d.flag, (const float*)d.p4, (bf16_t*)d.p5, (float*)d.p6}; pg8::gemm_phase(tid, lds, g, S, E);
        } else if (type == T_GEMM_BF16) {
            GET_LANE_TID();
            pg8::Gemm g{(const bf16_t*)d.p0, (const bf16_t*)d.p1, d.M, d.N, d.K, d.lda, d.ldb, d.grp}; pg8::StaticOrder S; S.init(d.M, d.N, G, bx);
            pg8::EpiBf16 E{(bf16_t*)d.p2, d.ldc, d.flag & 1, (const float*)d.p3, (const float*)d.p4, d.f0, (const float*)d.p5, (d.flag >> 1) & 1, (LAS float*)(lds + RL_LDS_OFF)}; pg8::gemm_phase(tid, lds, g, S, E);
        } else if (type == T_NORM) {
            GET_LANE_TID();
            norm_phase((const bf16_t*)d.p0, (const float*)d.p1, (float*)d.p2, gw, ngw, lane);
        } else if (type == T_POOL) {
            GET_LANE_TID();
            pool_phase<false>(tid, lds, d.p0, (const float*)d.p1, (bf16_t*)d.p2, vcu, G);
        } else if (type == T_ATT) {
            GET_LANE_TID();
            unsigned char* ws = args.ws;
            const float lam_init = d.f0;
            const float* lm = (const float*)d.p0;
            float s1 = lm[lane] * lm[HD + lane] + lm[64 + lane] * lm[HD + 64 + lane], s2 = lm[2 * HD + lane] * lm[3 * HD + lane] + lm[2 * HD + 64 + lane] * lm[3 * HD + 64 + lane];
            s1 = wave_sum(s1); s2 = wave_sum(s2);
            const float lam_full = __builtin_bit_cast(float, __builtin_amdgcn_readfirstlane(__builtin_bit_cast(int, expf(s1) - expf(s2) + lam_init)));
            att::Params P{(const bf16_t*)(ws + WS_Q), (const bf16_t*)(ws + WS_K), (const bf16_t*)(ws + WS_VT), (bf16_t*)(ws + WS_O), (const float*)d.p1, lam_full, d.f1};
            for (int pidx = vcu; pidx < 256; pidx += G) { const int h = pidx >> 5, s = pidx & 31;
                att::unit(wave, lds, P, h, 63 - s); att::unit(wave, lds, P, h, s); }
        } else {
            GET_LANE_TID();
            unsigned char* ws = args.ws;
            const float* pool_w = args.in[3]; const float* w_kv = args.in[6]; const float* w_q = args.in[7]; const float* w_o = args.in[10];
            const float* w_in = args.in[11]; const float* w_out = args.in[12];
            bf16_t* WPOOL = (bf16_t*)(ws + WS_WPOOL); bf16_t* WK = (bf16_t*)(ws + WS_WK); bf16_t* WV = (bf16_t*)(ws + WS_WV); bf16_t* WQ = (bf16_t*)(ws + WS_WQ);
            bf16_t* WO = (bf16_t*)(ws + WS_WO); bf16_t* WIN = (bf16_t*)(ws + WS_WIN); bf16_t* WOUT = (bf16_t*)(ws + WS_WOUT);
            float* cosT = (float*)(ws + WS_ROPE); float* sinT = cosT + SEQ * 16;
            LAS unsigned* scr = (LAS unsigned*)(lds + wave * 16384);
            constexpr int I_POOL = 8 * 64, I_SQ = 1024, I_IN = 4096, I_OUT = 4096;
            constexpr int NITEMS = I_POOL + 2 * I_SQ + 2 * I_SQ + 2 * I_SQ + 4 * I_IN + 4 * I_OUT;
            for (int it = gw; it < NITEMS; it += ngw) {
                int r = it;
                if (r < I_POOL) { const int mi = r / 64; transpose_matrix_items(pool_w + (size_t)mi * PG * PG, PG, PG, PG, WPOOL + (size_t)mi * PG * PG, scr, r % 64, lane, nullptr); continue; } r -= I_POOL;
                if (r < I_SQ) { transpose_matrix_items(w_kv, 2 * DM, DM, DM, WK, scr, r, lane, args.in[5]); continue; } r -= I_SQ;
                if (r < I_SQ) { transpose_matrix_items(w_kv + DM, 2 * DM, DM, DM, WV, scr, r, lane, args.in[5]); continue; } r -= I_SQ;
                if (r < 2 * I_SQ) { const int j = r / I_SQ; transpose_matrix_items(w_q + (size_t)j * DM * DM, DM, DM, DM, WQ + (size_t)j * DM * DM, scr, r % I_SQ, lane, args.in[1] + (2 + j) * DM); continue; } r -= 2 * I_SQ;
                if (r < 2 * I_SQ) { const int j = r / I_SQ; transpose_matrix_items(w_o + (size_t)j * DM * DM, DM, DM, DM, WO + (size_t)j * DM * DM, scr, r % I_SQ, lane, nullptr); continue; } r -= 2 * I_SQ;
                if (r < 4 * I_IN) { const int l = r / I_IN; transpose_matrix_items(w_in + (size_t)l * DM * FF, FF, DM, FF, WIN + (size_t)l * DM * FF, scr, r % I_IN, lane, args.in[2] + l * DM); continue; } r -= 4 * I_IN;
                { const int l = r / I_OUT; transpose_matrix_items(w_out + (size_t)l * DM * FF, DM, FF, DM, WOUT + (size_t)l * DM * FF, scr, r % I_OUT, lane, nullptr); }
            }
            for (int i = vcu * 512 + tid; i < SEQ * 16; i += G * 512) {
                const int pos = i >> 4, k = i & 15;
                const float inv_freq = powf(500000.0f, -(float)(2 * k) / 32.0f);
                const float ang = (float)pos * inv_freq;
                cosT[i] = cosf(ang); sinT[i] = sinf(ang);
            }
            pool_phase<true>(tid, lds, args.in[0], args.in[1], (bf16_t*)(ws + WS_XN2), vcu, G);
        }
        if (d.sync && ph + 1 < args.ph_hi) xcd_barrier(bar);
    }
}

static int build_program(Args& a) {
    unsigned char* ws = a.ws;
    const float* x = a.in[0]; const float* mix_norm = a.in[1]; const float* mlp_norm = a.in[2];
    const float* pool_scale = a.in[4]; const float* kv_norm = a.in[5];
    const float* lam = a.in[8]; const float* subln = a.in[9]; const float* final_norm = a.in[13];
    float* cosT = (float*)(ws + WS_ROPE); float* sinT = cosT + SEQ * 16;
    bf16_t* WPOOL = (bf16_t*)(ws + WS_WPOOL); bf16_t* WK = (bf16_t*)(ws + WS_WK); bf16_t* WV = (bf16_t*)(ws + WS_WV); bf16_t* WQ = (bf16_t*)(ws + WS_WQ);
    bf16_t* WO = (bf16_t*)(ws + WS_WO); bf16_t* WIN = (bf16_t*)(ws + WS_WIN); bf16_t* WOUT = (bf16_t*)(ws + WS_WOUT);
    float* H = (float*)(ws + WS_H); bf16_t* XN = (bf16_t*)(ws + WS_XN); bf16_t* XN2 = (bf16_t*)(ws + WS_XN2); bf16_t* U = (bf16_t*)(ws + WS_U);
    bf16_t* KB = (bf16_t*)(ws + WS_K); bf16_t* VT = (bf16_t*)(ws + WS_VT); bf16_t* QB = (bf16_t*)(ws + WS_Q); bf16_t* OB = (bf16_t*)(ws + WS_O);
    int n = 0;
    bf16_t* HB = XN; bf16_t* PB = XN2; float* SSQ = (float*)(ws + WS_SSQ);
    auto gemm_res = [&](const bf16_t* A, const bf16_t* Bt, int M, int N, int K, int lda, int ldb, int grp, const float* base, float* out, const float* cs) {
        PhaseDesc& d = a.d[n++]; d.type = T_GEMM_RES; d.p0 = A; d.p1 = Bt; d.p2 = out; d.p3 = base ? (const void*)base : (const void*)HB; d.flag = base ? 1 : 0; d.p4 = cs; d.p5 = HB; d.p6 = SSQ; d.M = M; d.N = N; d.K = K; d.lda = lda; d.ldb = ldb; d.grp = grp; d.ldc = N; d.sync = 1; };
    auto gemm_bf = [&](const bf16_t* A, const bf16_t* Bt, int M, int N, int K, bf16_t* out, int act, const float* ct, const float* st, float scale, int sync, int colscale) {
        PhaseDesc& d = a.d[n++]; d.type = T_GEMM_BF16; d.p0 = A; d.p1 = Bt; d.p2 = out; d.p3 = ct; d.p4 = st; d.p5 = SSQ; d.M = M; d.N = N; d.K = K; d.lda = K; d.ldb = K; d.grp = 0; d.ldc = N; d.flag = act | (colscale << 1); d.f0 = scale; d.sync = sync; };
    auto norm = [&](const float* Hh, const float* g1, void* o1, const float* g2, bf16_t* o2, int f32out) {
        PhaseDesc& d = a.d[n++]; d.type = T_NORM; d.p0 = Hh; d.p1 = g1; d.p2 = o1; d.p3 = g2; d.p4 = o2; d.flag = f32out; d.sync = 1; };
    { PhaseDesc& d = a.d[n++]; d.type = T_PRO; d.sync = 1; }
    for (int l = 0; l < 2; ++l) {
        gemm_res(PB, WPOOL + (size_t)l * DM * PG, SEQ, DM, PG, DM, PG, 2, l == 0 ? x : nullptr, H, pool_scale + l * DM);
        gemm_bf(HB, WIN + (size_t)l * DM * FF, SEQ, FF, DM, U, 1, nullptr, nullptr, 1.f, 1, 0);
        gemm_res(U, WOUT + (size_t)l * DM * FF, SEQ, DM, FF, FF, FF, 0, nullptr, H, nullptr);
        if (l == 0) { PhaseDesc& d = a.d[n++]; d.type = T_POOL; d.p0 = HB; d.p1 = mix_norm + DM; d.p2 = PB; d.sync = 1; }
    }
    const float qscale = 0.08838834764831845f * 1.4426950408889634f;
    for (int j = 0; j < 2; ++j) {
        const int l = 2 + j;
        if (j == 0) {
            gemm_bf(HB, WK, SEQ, DM, DM, KB, 0, cosT, sinT, 1.f, 0, 0);
            gemm_bf(WV, HB, DM, SEQ, DM, VT, 0, nullptr, nullptr, 1.f, 0, 1);
        }
        gemm_bf(HB, WQ + (size_t)j * DM * DM, SEQ, DM, DM, QB, 0, cosT, sinT, qscale, 1, 0);
        const float lam_init = (float)(0.8 - 0.6 * exp(-0.3 * (double)l));
        { PhaseDesc& d = a.d[n++]; d.type = T_ATT; d.p0 = lam + j * 4 * HD; d.p1 = subln + j * VD; d.f0 = lam_init; d.f1 = 1.f - lam_init; d.sync = 1; }
        gemm_res(OB, WO + (size_t)j * DM * DM, SEQ, DM, DM, DM, DM, 0, nullptr, H, nullptr);
        gemm_bf(HB, WIN + (size_t)l * DM * FF, SEQ, FF, DM, U, 1, nullptr, nullptr, 1.f, 1, 0);
        gemm_res(U, WOUT + (size_t)l * DM * FF, SEQ, DM, FF, FF, FF, 0, nullptr, H, nullptr);
        if (j == 1) norm((const float*)HB, final_norm, a.out, nullptr, nullptr, 1);
    }
    (void)kv_norm; (void)mlp_norm;
    return n;
}

extern "C" void kernel_launch(void* const* d_in, const int* in_sizes, int n_in, void* d_out, int out_size, void* d_ws, size_t ws_size, hipStream_t stream) {
    static int grid = 0;
    if (grid == 0) {
        if (n_in != 14 || out_size != SEQ * DM || ws_size < WS_END) { fprintf(stderr, "kernel_launch: unexpected shapes (n_in %d out %d ws %zu)\n", n_in, out_size, ws_size); grid = -1; return; }
        int dev = 0, cus = 0, per_cu = 0;
        (void)hipGetDevice(&dev); (void)hipDeviceGetAttribute(&cus, hipDeviceAttributeMultiprocessorCount, dev);
        (void)hipFuncSetAttribute((const void*)fwd, hipFuncAttributeMaxDynamicSharedMemorySize, LDS_BYTES);
        (void)hipOccupancyMaxActiveBlocksPerMultiprocessor(&per_cu, (const void*)fwd, 512, LDS_BYTES);
        (void)hipGetLastError();
        if (per_cu < 1) per_cu = 1;
        grid = cus * per_cu;
        if (grid > 256) grid = 256;
    }
    if (grid < 0) return;
    Args a{};
    for (int i = 0; i < 14; ++i) a.in[i] = (const float*)d_in[i];
    a.out = (float*)d_out; a.ws = (unsigned char*)d_ws;
    const int nph = build_program(a);
    (void)hipMemsetAsync((char*)d_ws + WS_CTL, 0, CTL_BYTES, stream);
#if MK_ONE_LAUNCH
    a.ph_lo = 0; a.ph_hi = nph;
    void* kargs[] = {&a};
    hipError_t e = hipLaunchCooperativeKernel((const void*)fwd, dim3(grid), dim3(512), kargs, LDS_BYTES, stream);
    if (e != hipSuccess) fprintf(stderr, "cooperative launch failed: %s (grid %d)\n", hipGetErrorString(e), grid);
#else
    for (int p = 0; p < nph; ++p) { a.ph_lo = p; a.ph_hi = p + 1; hipLaunchKernelGGL(fwd, dim3(grid), dim3(512), LDS_BYTES, stream, a); }
#endif
}
```

```cpp
#include <hip/hip_runtime.h>
#include <hip/hip_cooperative_groups.h>
#include <cstdio>
#include <cstdint>
namespace cg = cooperative_groups;

#ifndef MK_ONE_LAUNCH
#define MK_ONE_LAUNCH 1
#endif

#define LAS __attribute__((address_space(3)))
typedef unsigned short bf16_t;
typedef short bf16x8 __attribute__((ext_vector_type(8)));
typedef float f32x4 __attribute__((ext_vector_type(4)));
typedef float f32x16 __attribute__((ext_vector_type(16)));
typedef unsigned u32x4 __attribute__((ext_vector_type(4)));
typedef unsigned u32x2 __attribute__((ext_vector_type(2)));

constexpr int SEQ = 8192, DM = 2048, FF = 8192, NH = 8, HD = 128, VD = 256, PG = 512;
constexpr float EPS = 1e-6f;
constexpr size_t MiB = 1u << 20;
constexpr size_t WS_ROPE = 1 * MiB, WS_WPOOL = 2 * MiB, WS_WK = 8 * MiB, WS_WV = 16 * MiB, WS_WQ = 24 * MiB, WS_WO = 40 * MiB,
                 WS_WIN = 64 * MiB, WS_WOUT = 192 * MiB, WS_H = 320 * MiB, WS_XN = 384 * MiB, WS_XN2 = 416 * MiB, WS_U = 448 * MiB,
                 WS_K = 576 * MiB, WS_VT = 608 * MiB, WS_Q = 640 * MiB, WS_O = 672 * MiB, WS_END = 704 * MiB;
constexpr int LDS_BYTES = 147456;
constexpr int BAR_LDS_OFF = 147456 - 64, RL_LDS_OFF = 131072;
constexpr size_t WS_SSQ = 6 * MiB;
constexpr size_t WS_CTL = 0, CTL_BYTES = 16384;

__device__ __forceinline__ unsigned cvt_pk_bf16(float lo, float hi) { unsigned r; asm volatile("v_cvt_pk_bf16_f32 %0, %1, %2" : "=v"(r) : "v"(lo), "v"(hi)); return r; }
__device__ __forceinline__ f32x4 bf4_to_f32(u32x2 w) { f32x4 r; r.x = __uint_as_float(w.x << 16); r.y = __uint_as_float(w.x & 0xffff0000u); r.z = __uint_as_float(w.y << 16); r.w = __uint_as_float(w.y & 0xffff0000u); return r; }
template <bool F32> __device__ __forceinline__ f32x4 ld4(const void* base, size_t idx) { if (F32) return *(const f32x4*)((const float*)base + idx); return bf4_to_f32(*(const u32x2*)((const bf16_t*)base + idx)); }
__device__ __forceinline__ float wave_sum(float v) {
#pragma unroll
    for (int o = 1; o < 64; o <<= 1) v += __shfl_xor(v, o);
    return v;
}

namespace pg8 {
constexpr int BM = 256, BK = 64, HALF = 128, HTB = HALF * BK * 2, STAGE_BYTES = 8 * HTB, NXCD = 8, WGM = 8;
__host__ __device__ __forceinline__ int lds_byte(int r, int c) { const int st = (r >> 4) * 2 + (c >> 5), rr = r & 15, cc = c & 31, ob = rr * 64 + cc * 2; return st * 1024 + (ob ^ (((ob >> 9) & 1) << 5)); }
__host__ __device__ __forceinline__ void stage_rc(int b, int& R, int& C) { const int st = b / 1024, sb = b % 1024, swz = sb ^ (((sb >> 9) & 1) << 5); R = (st >> 1) * 16 + swz / 64; C = (st & 1) * 32 + (swz % 64) / 2; }
__host__ __device__ __forceinline__ int perm32(int rho) { const int n = rho >> 4, i = rho & 15; return 8 * (i >> 2) + 4 * n + (i & 3); }

struct Unit { int pm, pn; };
struct Gemm { const bf16_t* A; const bf16_t* Bt; int M, N, K, lda, ldb, grp; };

struct StaticOrder {
    int nM, nN, nwg, G, c;
    __host__ __device__ void init(int M, int N, int G_, int c_) { nM = M / BM; nN = N / BM; nwg = nM * nN; G = G_; c = c_; }
    __host__ __device__ bool next(int i, Unit& u) const {
        const long L = (long)i * G + c; if (L >= nwg) return false;
        int wgid = (int)L; { const int q = nwg / NXCD, r = nwg % NXCD, xcd = wgid % NXCD, off = wgid / NXCD; wgid = (xcd < r ? xcd * (q + 1) : r * (q + 1) + (xcd - r) * q) + off; }
        const int nig = WGM * nN, gid = wgid / nig, fm = gid * WGM, gsz = (nM - fm) < WGM ? (nM - fm) : WGM;
        u.pm = fm + ((wgid % nig) % gsz); u.pn = (wgid % nig) / gsz; return true;
    }
};

struct EpiBf16 {
    static constexpr bool PERM = true;
    bf16_t* O; int ldc; int act; const float* cosT; const float* sinT; float scale; const float* ssq; int colscale; LAS float* rl;
    __device__ __forceinline__ void operator()(const f32x4 (&acc)[2][2][4][2], const Unit& u, int wr, int wc, int fr, int fq) const {
        const int row0 = u.pm * BM + wr * 64 + fr, col0 = u.pn * BM + wc * 32 + 8 * fq;
        const bool rope = (cosT != nullptr) && (wc == 0);
        if (ssq) {
            if (wr == 0) { const int i = wc * 64 + fq * 16 + fr; const f32x4* sp = (const f32x4*)(ssq + (size_t)((colscale ? u.pn : u.pm) * BM + i) * 32);
                f32x4 t = sp[0];
#pragma unroll
                for (int k = 1; k < 8; ++k) t += sp[k];
                rl[i] = rsqrtf(((t.x + t.y) + (t.z + t.w)) * (1.f / DM) + EPS); }
            asm volatile("s_waitcnt lgkmcnt(0)" ::: "memory"); __builtin_amdgcn_s_barrier(); asm volatile("" ::: "memory");
        }
        f32x4 cs0[2], cs1[2];
#pragma unroll
        for (int bj = 0; bj < 2; ++bj) { cs0[bj] = (f32x4){scale, scale, scale, scale}; cs1[bj] = cs0[bj];
            if (ssq && colscale) { const LAS float* rp = rl + bj * HALF + wc * 32 + 8 * fq; cs0[bj] = *(const LAS f32x4*)rp * scale; cs1[bj] = *(const LAS f32x4*)(rp + 4) * scale; } }
#pragma unroll
        for (int ai = 0; ai < 2; ++ai)
#pragma unroll
            for (int m = 0; m < 4; ++m) { const int row = row0 + ai * HALF + m * 16; bf16_t* rowp = O + (size_t)row * ldc + col0;
                const float rs = (ssq && !colscale) ? rl[ai * HALF + wr * 64 + m * 16 + fr] : 1.f;
                f32x4 c0 = {1.f, 1.f, 1.f, 1.f}, c1 = c0, s0 = {0.f, 0.f, 0.f, 0.f}, s1 = s0;
                if (rope) { const float* cp = cosT + (size_t)row * 16 + 8 * (fq & 1); const float* sp = sinT + (size_t)row * 16 + 8 * (fq & 1);
                    c0 = *(const f32x4*)cp; c1 = *(const f32x4*)(cp + 4); s0 = *(const f32x4*)sp; s1 = *(const f32x4*)(sp + 4);
                    if (fq < 2) { s0 = -s0; s1 = -s1; } }
#pragma unroll
                for (int bj = 0; bj < 2; ++bj) { f32x4 v0 = acc[ai][bj][m][0] * rs, v1 = acc[ai][bj][m][1] * rs;
                    if (rope) {
#pragma unroll
                        for (int j = 0; j < 4; ++j) { const float p0 = __shfl_xor(v0[j], 32), p1 = __shfl_xor(v1[j], 32);
                            v0[j] = v0[j] * c0[j] + p0 * s0[j]; v1[j] = v1[j] * c1[j] + p1 * s1[j]; } }
                    v0 = v0 * cs0[bj]; v1 = v1 * cs1[bj];
                    if (act) {
#pragma unroll
                        for (int j = 0; j < 4; ++j) { const float a = fmaxf(v0[j], 0.f), b = fmaxf(v1[j], 0.f); v0[j] = a * a; v1[j] = b * b; } }
                    u32x4 w; w.x = cvt_pk_bf16(v0[0], v0[1]); w.y = cvt_pk_bf16(v0[2], v0[3]); w.z = cvt_pk_bf16(v1[0], v1[1]); w.w = cvt_pk_bf16(v1[2], v1[3]);
                    *(u32x4*)(rowp + bj * HALF) = w; }
                asm volatile("" ::: "memory"); }
    }
};
struct EpiRes {
    static constexpr bool PERM = false;
    const void* base; int base_f32; const float* cs; bf16_t* hb; float* ssq;
    __device__ __forceinline__ void operator()(const f32x4 (&acc)[2][2][4][2], const Unit& u, int wr, int wc, int fr, int fq) const {
        const int col0 = u.pn * BM + wc * 32 + 4 * fq;
#pragma unroll
        for (int ai = 0; ai < 2; ++ai)
#pragma unroll
            for (int m = 0; m < 4; ++m) { const int row = u.pm * BM + ai * HALF + wr * 64 + m * 16 + fr; const size_t off = (size_t)row * DM + col0;
                float sq = 0.f;
#pragma unroll
                for (int bj = 0; bj < 2; ++bj)
#pragma unroll
                    for (int n = 0; n < 2; ++n) { const f32x4 bs = base_f32 ? ld4<true>(base, off + bj * HALF + n * 16) : ld4<false>(base, off + bj * HALF + n * 16);
                        const f32x4 csv = cs ? *(const f32x4*)(cs + col0 + bj * HALF + n * 16) : (f32x4){1.f, 1.f, 1.f, 1.f};
                        const f32x4 v = bs + acc[ai][bj][m][n] * csv;
                        sq += (v.x * v.x + v.y * v.y) + (v.z * v.z + v.w * v.w);
                        u32x2 w; w.x = cvt_pk_bf16(v.x, v.y); w.y = cvt_pk_bf16(v.z, v.w); *(u32x2*)(hb + off + bj * HALF + n * 16) = w; }
                sq += __shfl_xor(sq, 16); sq += __shfl_xor(sq, 32);
                if (fq == 0) ssq[(size_t)row * 32 + u.pn * 4 + wc] = sq;
                asm volatile("" ::: "memory"); }
    }
};

template <class Epi>
__device__ __forceinline__ void gemm_phase(const int tid, LAS unsigned char* lds, const Gemm g, const StaticOrder& S, const Epi& E) {
    const int wid = __builtin_amdgcn_readfirstlane(tid >> 6), lane = tid & 63, wr = wid >> 2, wc = wid & 3, fr = lane & 15, fq = lane >> 4;
    const int K = g.K, nt = K / BK;
    unsigned voffA[2], voffB[2];
#pragma unroll
    for (int i = 0; i < 2; ++i) { int R, C; stage_rc(tid * 16 + i * 8192, R, C); const int Rb = Epi::PERM ? ((R & ~31) + perm32(R & 31)) : R;
        voffA[i] = (unsigned)(R * g.lda + C) * 2u; voffB[i] = (unsigned)(Rb * g.ldb + C) * 2u; }
    const size_t kstep = (size_t)(BK * 2);
    const size_t hstepA = (size_t)HALF * g.lda * 2, hstepB = (size_t)HALF * g.ldb * 2;
    const size_t tstepA = 2 * hstepA, tstepB = 2 * hstepB;
    const unsigned ldsw = (unsigned)wid * 1024u;
    const int aoff = lds_byte(wr * 64 + fr, fq * 8), boff = lds_byte(wc * 32 + fr, fq * 8);
#define PG8_SA(b, h) (((b) * 2 + (h)) * HTB)
#define PG8_SB(b, h) ((4 + (b) * 2 + (h)) * HTB)
#define PG8_STAGE(bufoff, gbase, voff) do { _Pragma("unroll") for (int _i = 0; _i < 2; ++_i) \
        __builtin_amdgcn_global_load_lds((const unsigned*)((const char*)(gbase) + (voff)[_i]), (LAS unsigned*)(lds + (bufoff) + ldsw + _i * 8192), 16, 0, 0); } while (0)
#define PG8_LDA(dst, b, h) do { _Pragma("unroll") for (int m = 0; m < 4; ++m) _Pragma("unroll") for (int k = 0; k < 2; ++k) dst[m][k] = *(const LAS bf16x8*)(lds + PG8_SA(b, h) + aoff + m * 2048 + k * 1024); } while (0)
#define PG8_LDB(dst, b, h) do { _Pragma("unroll") for (int n = 0; n < 2; ++n) _Pragma("unroll") for (int k = 0; k < 2; ++k) dst[n][k] = *(const LAS bf16x8*)(lds + PG8_SB(b, h) + boff + n * 2048 + k * 1024); } while (0)
#define PG8_MMA(ai, bj, At, Bt) do { __builtin_amdgcn_s_setprio(1); _Pragma("unroll") for (int m = 0; m < 4; ++m) _Pragma("unroll") for (int n = 0; n < 2; ++n) _Pragma("unroll") for (int k = 0; k < 2; ++k) \
        acc[ai][bj][m][n] = __builtin_amdgcn_mfma_f32_16x16x32_bf16(Bt[n][k], At[m][k], acc[ai][bj][m][n], 0, 0, 0); __builtin_amdgcn_s_setprio(0); } while (0)
#define PG8_WAIT_V(n) asm volatile("s_waitcnt vmcnt(" #n ")" ::: "memory")
#define PG8_WAIT_L(n) asm volatile("s_waitcnt lgkmcnt(" #n ")" ::: "memory")
#define PG8_BAR __builtin_amdgcn_s_barrier()
#define PG8_SCHED __builtin_amdgcn_sched_barrier(0)
#define PG8_ABASE(u) ((const char*)g.A + (size_t)(u).pm * tstepA + (g.grp ? (size_t)((u).pn / g.grp) * K * 2 : (size_t)0))
#define PG8_BBASE(u) ((const char*)g.Bt + (size_t)(u).pn * tstepB)
    Unit cur, nxt; int ui = 0;
    if (!S.next(0, cur)) return;
    f32x4 acc[2][2][4][2];
#pragma unroll
    for (int a = 0; a < 2; ++a)
#pragma unroll
        for (int b = 0; b < 2; ++b)
#pragma unroll
            for (int m = 0; m < 4; ++m)
#pragma unroll
                for (int n = 0; n < 2; ++n) acc[a][b][m][n] = (f32x4){0.f, 0.f, 0.f, 0.f};
    bf16x8 At[4][2], B0[2][2], B1[2][2];
    const char* cA = PG8_ABASE(cur); const char* cB = PG8_BBASE(cur);
    PG8_STAGE(PG8_SB(0, 0), cB, voffB); PG8_STAGE(PG8_SB(0, 1), cB + hstepB, voffB); PG8_STAGE(PG8_SA(0, 0), cA, voffA); PG8_STAGE(PG8_SA(0, 1), cA + hstepA, voffA);
    if (wr == 1) PG8_BAR;
    PG8_WAIT_V(2); PG8_BAR;
    PG8_STAGE(PG8_SB(1, 0), cB + kstep, voffB); PG8_STAGE(PG8_SA(1, 0), cA + kstep, voffA); PG8_STAGE(PG8_SB(1, 1), cB + hstepB + kstep, voffB);
    PG8_WAIT_V(6); PG8_BAR;
    for (;;) {
        const bool has_next = S.next(ui + 1, nxt);
        const char* nA = has_next ? PG8_ABASE(nxt) : cA; const char* nB = has_next ? PG8_BBASE(nxt) : cB;
        for (int t = 0; t < nt; t += 2) {
            const bool last = (t == nt - 2);
            const char* a1 = cA + (size_t)(t + 1) * kstep;
            const char* a2 = last ? nA : cA + (size_t)(t + 2) * kstep; const char* b2 = last ? nB : cB + (size_t)(t + 2) * kstep;
            const char* a3 = a2 + kstep; const char* b3 = b2 + kstep;
            PG8_LDB(B0, 0, 0); PG8_LDB(B1, 0, 1); PG8_SCHED; PG8_LDA(At, 0, 0); PG8_STAGE(PG8_SA(1, 1), a1 + hstepA, voffA);
            PG8_WAIT_V(8); PG8_WAIT_L(0); PG8_BAR; PG8_MMA(0, 0, At, B0); PG8_MMA(0, 1, At, B1); PG8_BAR; PG8_SCHED;
            PG8_LDA(At, 0, 1); PG8_STAGE(PG8_SB(0, 0), b2, voffB); PG8_STAGE(PG8_SB(0, 1), b2 + hstepB, voffB); PG8_STAGE(PG8_SA(0, 0), a2, voffA);
            PG8_WAIT_V(8); PG8_WAIT_L(0); PG8_BAR; PG8_MMA(1, 0, At, B0); PG8_MMA(1, 1, At, B1); PG8_BAR; PG8_SCHED;
            PG8_LDB(B0, 1, 0); PG8_LDB(B1, 1, 1); PG8_SCHED; PG8_LDA(At, 1, 0); PG8_STAGE(PG8_SA(0, 1), a2 + hstepA, voffA);
            PG8_WAIT_V(8); PG8_WAIT_L(0); PG8_BAR; PG8_MMA(0, 0, At, B0); PG8_MMA(0, 1, At, B1); PG8_BAR; PG8_SCHED;
            PG8_LDA(At, 1, 1); PG8_STAGE(PG8_SB(1, 0), b3, voffB); PG8_STAGE(PG8_SB(1, 1), b3 + hstepB, voffB); PG8_STAGE(PG8_SA(1, 0), a3, voffA);
            PG8_WAIT_V(8); PG8_WAIT_L(0); PG8_BAR; PG8_MMA(1, 0, At, B0); PG8_MMA(1, 1, At, B1); PG8_BAR; PG8_SCHED;
        }
        if (wr == 0) PG8_BAR;
        { int fr2 = fr, fq2 = fq; asm volatile("" : "+v"(fr2), "+v"(fq2)); E(acc, cur, wr, wc, fr2, fq2); }
        if (!has_next) break;
#pragma unroll
        for (int a = 0; a < 2; ++a)
#pragma unroll
            for (int b = 0; b < 2; ++b)
#pragma unroll
                for (int m = 0; m < 4; ++m)
#pragma unroll
                    for (int n = 0; n < 2; ++n) acc[a][b][m][n] = (f32x4){0.f, 0.f, 0.f, 0.f};
        cur = nxt; cA = nA; cB = nB; ++ui;
        if (wr == 1) PG8_BAR;
    }
    PG8_WAIT_V(0);
    PG8_BAR;
#undef PG8_SA
#undef PG8_SB
#undef PG8_STAGE
#undef PG8_LDA
#undef PG8_LDB
#undef PG8_MMA
#undef PG8_WAIT_V
#undef PG8_WAIT_L
#undef PG8_BAR
#undef PG8_SCHED
#undef PG8_ABASE
#undef PG8_BBASE
}
}

namespace att {
constexpr int KT = 32768, STG = 65536, WSOFF = 131072;
__device__ __forceinline__ int crow(int r, int hi) { return (r & 3) + 8 * (r >> 2) + 4 * hi; }
struct Params { const bf16_t* Q; const bf16_t* K; const bf16_t* VT; bf16_t* O; const float* subln; float lam_full, out_scale; };

__device__ __forceinline__ void unit(const int wid, LAS unsigned char* lds, const Params& P, int h, int qb) {
    int lane; asm volatile("v_mbcnt_lo_u32_b32 %0, -1, 0\n\tv_mbcnt_hi_u32_b32 %0, -1, %0" : "=v"(lane));
    const int r32 = lane & 31, hi = lane >> 5;
    const int c = wid >> 2, rb = wid & 3, q0 = qb * 128, cq = 2 * qb + (rb >> 1), NT = 2 * qb + 2;
    LAS float* wsf = (LAS float*)(lds + WSOFF) + wid * 64;
    unsigned koff0, voff0;
    { const int row = 4 * wid + (lane >> 4), ch = (lane & 15) ^ (row & 15);
      koff0 = (unsigned)((row * DM + (h * 2) * HD + ch * 8) * 2);
      const int e = 8 * wid + (lane >> 3), cv = (lane & 7) ^ ((e >> 1) & 7);
      voff0 = (unsigned)(((h * VD + e) * SEQ + cv * 8) * 2); }
    const char* Kc = (const char*)P.K; const char* Vc = (const char*)P.VT;
#define ATT_ISSUE(t, st) do { _Pragma("unroll") for (int _i = 0; _i < 4; ++_i) { \
        __builtin_amdgcn_global_load_lds((const unsigned*)(Kc + ((size_t)(t) * (64 * DM * 2) + (size_t)((_i & 1) * 32 * DM * 2 + (_i >> 1) * HD * 2)) + koff0), (LAS unsigned*)(lds + (st) * STG + (_i * 8 + wid) * 1024), 16, 0, 0); \
        __builtin_amdgcn_global_load_lds((const unsigned*)(Vc + ((size_t)(t) * 128 + (size_t)_i * (64 * SEQ * 2)) + voff0), (LAS unsigned*)(lds + (st) * STG + KT + (_i * 8 + wid) * 1024), 16, 0, 0); } } while (0)
    ATT_ISSUE(0, 0);
    bf16x8 qr[8];
    { const bf16_t* Qw = P.Q + (size_t)(q0 + 32 * rb + r32) * DM + (h * 2 + c) * HD + hi * 8;
#pragma unroll
      for (int d0 = 0; d0 < 8; ++d0) qr[d0] = *(const bf16x8*)(Qw + d0 * 16); }
    float m_reg = -1e30f, l_reg = 0.f;
    f32x16 o[8];
#pragma unroll
    for (int nb = 0; nb < 8; ++nb)
#pragma unroll
        for (int r = 0; r < 16; ++r) o[nb][r] = 0.f;
    const int ky = (hi ^ (r32 & 15));
    const unsigned kbase = (unsigned)(c * 16384 + r32 * 256);
    const int vsw = hi ^ ((r32 >> 1) & 7);
    const unsigned vbase = (unsigned)(KT + r32 * 128);
    for (int t = 0; t < NT; ++t) {
        asm volatile("s_waitcnt vmcnt(0)" ::: "memory");
        __syncthreads();
        if (t + 1 < NT) ATT_ISSUE(t + 1, (t + 1) & 1);
        if (t <= cq) {
            LAS unsigned char* st = lds + (t & 1) * STG;
            f32x16 p0, p1;
#pragma unroll
            for (int r = 0; r < 16; ++r) { p0[r] = 0.f; p1[r] = 0.f; }
            {
                bf16x8 ka[8];
#define ATT_KRD(d0, hf) (*(const LAS bf16x8*)(st + kbase + (unsigned)(((2 * (d0)) ^ ky) << 4) + (hf) * 8192))
#pragma unroll
                for (int i = 0; i < 4; ++i) { ka[2 * i] = ATT_KRD(i, 0); ka[2 * i + 1] = ATT_KRD(i, 1); }
                __builtin_amdgcn_sched_barrier(0);
#pragma unroll
                for (int i = 0; i < 4; ++i) {
                    p0 = __builtin_amdgcn_mfma_f32_32x32x16_bf16(ka[2 * i], qr[i], p0, 0, 0, 0);
                    p1 = __builtin_amdgcn_mfma_f32_32x32x16_bf16(ka[2 * i + 1], qr[i], p1, 0, 0, 0);
                    ka[2 * i] = ATT_KRD(4 + i, 0); ka[2 * i + 1] = ATT_KRD(4 + i, 1);
                    __builtin_amdgcn_sched_barrier(0);
                }
#pragma unroll
                for (int i = 0; i < 4; ++i) {
                    p0 = __builtin_amdgcn_mfma_f32_32x32x16_bf16(ka[2 * i], qr[4 + i], p0, 0, 0, 0);
                    p1 = __builtin_amdgcn_mfma_f32_32x32x16_bf16(ka[2 * i + 1], qr[4 + i], p1, 0, 0, 0);
                    __builtin_amdgcn_sched_barrier(0);
                }
#undef ATT_KRD
            }
            __builtin_amdgcn_sched_barrier(0);
            float pmax = p0[0];
#pragma unroll
            for (int r = 1; r < 16; ++r) pmax = fmaxf(pmax, p0[r]);
#pragma unroll
            for (int r = 0; r < 16; ++r) pmax = fmaxf(pmax, p1[r]);
            { auto rr = __builtin_amdgcn_permlane32_swap(__float_as_uint(pmax), __float_as_uint(pmax), false, false);
              pmax = fmaxf(__uint_as_float(rr[0]), __uint_as_float(rr[1])); }
            const bool grow = __any(pmax - m_reg > 8.f);
            float alpha = 1.f;
            if (grow) { const float mnew = fmaxf(m_reg, pmax); alpha = __builtin_amdgcn_exp2f(m_reg - mnew); m_reg = mnew; }
            const float mn = m_reg;
#pragma unroll
            for (int r = 0; r < 16; ++r) { p0[r] = __builtin_amdgcn_exp2f(p0[r] - mn); p1[r] = __builtin_amdgcn_exp2f(p1[r] - mn); }
            float ps = 0.f;
#pragma unroll
            for (int r = 0; r < 16; ++r) ps += p0[r] + p1[r];
            { auto rr = __builtin_amdgcn_permlane32_swap(__float_as_uint(ps), __float_as_uint(ps), false, false);
              ps = __uint_as_float(rr[0]) + __uint_as_float(rr[1]); }
            l_reg = l_reg * alpha + ps;
            if (grow) {
                if (hi == 0) wsf[r32] = alpha;
                asm volatile("s_waitcnt lgkmcnt(0)" ::: "memory");
#pragma unroll
                for (int r = 0; r < 16; ++r) { const float al = wsf[crow(r, hi)];
#pragma unroll
                    for (int nb = 0; nb < 8; ++nb) o[nb][r] *= al; }
            }
            __builtin_amdgcn_sched_barrier(0);
            bf16x8 pa[4];
#define ATT_PK4(Pv, BASE, OUT) do { const unsigned a0 = cvt_pk_bf16(Pv[BASE + 0], Pv[BASE + 1]), a1 = cvt_pk_bf16(Pv[BASE + 2], Pv[BASE + 3]); \
            const unsigned b0 = cvt_pk_bf16(Pv[BASE + 4], Pv[BASE + 5]), b1 = cvt_pk_bf16(Pv[BASE + 6], Pv[BASE + 7]); \
            auto r0 = __builtin_amdgcn_permlane32_swap(a0, b0, false, false); auto r1 = __builtin_amdgcn_permlane32_swap(a1, b1, false, false); \
            u32x4 w = {r0[0], r1[0], r0[1], r1[1]}; OUT = __builtin_bit_cast(bf16x8, w); } while (0)
            ATT_PK4(p0, 0, pa[0]); ATT_PK4(p0, 8, pa[1]); ATT_PK4(p1, 0, pa[2]); ATT_PK4(p1, 8, pa[3]);
#undef ATT_PK4
            {
                bf16x8 vf[8];
                __builtin_amdgcn_s_setprio(1);
#define ATT_VRD(s_, nb) (*(const LAS bf16x8*)(st + vbase + (unsigned)(((2 * (s_)) ^ vsw) << 4) + (nb) * 4096))
#pragma unroll
                for (int nb = 0; nb < 8; ++nb) vf[nb] = ATT_VRD(0, nb);
                __builtin_amdgcn_sched_barrier(0);
#pragma unroll
                for (int s = 0; s < 4; ++s) {
#pragma unroll
                    for (int nb = 0; nb < 8; ++nb) {
                        o[nb] = __builtin_amdgcn_mfma_f32_32x32x16_bf16(pa[s], vf[nb], o[nb], 0, 0, 0);
                        if (s < 3) vf[nb] = ATT_VRD(s + 1, nb);
                        if (nb & 1) __builtin_amdgcn_sched_barrier(0);
                    }
                }
#undef ATT_VRD
                __builtin_amdgcn_s_setprio(0);
            }
        }
    }
#undef ATT_ISSUE
    if (hi == 0) wsf[r32] = l_reg;
    asm volatile("s_waitcnt lgkmcnt(0)" ::: "memory");
    int lane2 = lane; asm volatile("" : "+v"(lane2));
    const int r32e = lane2 & 31, hie = lane2 >> 5;
    __syncthreads();
    LAS float* X = (LAS float*)lds + rb * 8192 + lane2;
    if (c == 1) {
#pragma unroll
        for (int r = 0; r < 16; ++r) { const float rl = P.lam_full / wsf[crow(r, hie)];
#pragma unroll
            for (int nb = 0; nb < 8; ++nb) X[(nb * 16 + r) * 64] = o[nb][r] * rl;
            if ((r & 3) == 3) __builtin_amdgcn_sched_barrier(0); }
    }
    __syncthreads();
    if (c == 0) {
        bf16_t* Ob = P.O + (size_t)(q0 + 32 * rb + 4 * hie) * DM + h * VD + r32e;
        float gsub[8];
#pragma unroll
        for (int nb = 0; nb < 8; ++nb) gsub[nb] = P.subln[nb * 32 + r32e] * P.out_scale;
#pragma unroll
        for (int r = 0; r < 16; ++r) { const float rl = 1.f / wsf[crow(r, hie)];
            float v[8], sq = 0.f;
#pragma unroll
            for (int nb = 0; nb < 8; ++nb) { v[nb] = o[nb][r] * rl - X[(nb * 16 + r) * 64]; sq += v[nb] * v[nb]; }
#define ATT_SWZ(v, x) __builtin_bit_cast(float, __builtin_amdgcn_ds_swizzle(__builtin_bit_cast(int, (v)), 0x1f | ((x) << 10)))
            sq += ATT_SWZ(sq, 1); sq += ATT_SWZ(sq, 2); sq += ATT_SWZ(sq, 4); sq += ATT_SWZ(sq, 8); sq += ATT_SWZ(sq, 16);
#undef ATT_SWZ
            const float sc = rsqrtf(sq * (1.f / VD) + EPS);
#pragma unroll
            for (int nb = 0; nb < 8; ++nb) { const unsigned w = cvt_pk_bf16(v[nb] * sc * gsub[nb], 0.f); Ob[(size_t)((r & 3) + 8 * (r >> 2)) * DM + nb * 32] = (bf16_t)(w & 0xffffu); }
            __builtin_amdgcn_sched_barrier(0); }
    }
    __syncthreads();
}
}

enum { T_PRO = 0, T_GEMM_RES = 1, T_GEMM_BF16 = 2, T_NORM = 3, T_POOL = 4, T_ATT = 5, T_COMB = 6 };
struct PhaseDesc { const void* p0; const void* p1; void* p2; const void* p3; const void* p4; void* p5; void* p6; int type, M, N, K, lda, ldb, grp, ldc, flag, sync; float f0, f1; };
constexpr int MAX_PH = 30;
struct Args { const float* in[14]; float* out; unsigned char* ws; int ph_lo, ph_hi; PhaseDesc d[MAX_PH]; };

__device__ __forceinline__ void transpose_item(const float* W, int ldw, bf16_t* WT, int ldt, LAS unsigned* scr, int k0, int n0, int lane, const float* g) {
    const int q = lane >> 4, c4 = (lane & 15) * 4;
    const float* src = W + (size_t)(k0 + 2 * q) * ldw + n0 + c4;
    f32x4 a[8], b[8];
#pragma unroll
    for (int i2 = 0; i2 < 8; ++i2) { a[i2] = *(const f32x4*)(src + (size_t)(8 * i2) * ldw); b[i2] = *(const f32x4*)(src + (size_t)(8 * i2 + 1) * ldw); }
    if (g) {
#pragma unroll
        for (int i2 = 0; i2 < 8; ++i2) { const float ga = g[k0 + 8 * i2 + 2 * q], gb = g[k0 + 8 * i2 + 2 * q + 1]; a[i2] = a[i2] * ga; b[i2] = b[i2] * gb; }
    }
#pragma unroll
    for (int i2 = 0; i2 < 8; ++i2) { LAS unsigned* d = scr + c4 * 33 + 4 * i2 + q;
        d[0 * 33] = cvt_pk_bf16(a[i2].x, b[i2].x); d[1 * 33] = cvt_pk_bf16(a[i2].y, b[i2].y); d[2 * 33] = cvt_pk_bf16(a[i2].z, b[i2].z); d[3 * 33] = cvt_pk_bf16(a[i2].w, b[i2].w); }
    asm volatile("s_waitcnt lgkmcnt(0)" ::: "memory");
    const int c8 = lane & 7;
#pragma unroll
    for (int i = 0; i < 8; ++i) { const int n = (lane >> 3) + 8 * i; const LAS unsigned* sp = scr + n * 33 + 4 * c8;
        u32x4 o; o.x = sp[0]; o.y = sp[1]; o.z = sp[2]; o.w = sp[3];
        *(u32x4*)(WT + (size_t)(n0 + n) * ldt + k0 + 8 * c8) = o; }
    asm volatile("s_waitcnt lgkmcnt(0)" ::: "memory");
}
__device__ __forceinline__ void transpose_matrix_items(const float* src, int ldw, int K, int N, bf16_t* dst, LAS unsigned* scr, int item, int lane, const float* g) {
    const int nblk = N / 64, kb = item / nblk, nb = item % nblk;
    transpose_item(src, ldw, dst, K, scr, 64 * kb, 64 * nb, lane, g);
}

__device__ __forceinline__ void norm_row(const bf16_t* xrow, const float* g1, float* of, int lane) {
    f32x4 v[8]; float s = 0.f;
#pragma unroll
    for (int j = 0; j < 8; ++j) { v[j] = ld4<false>(xrow, (size_t)(lane + 64 * j) * 4); s += (v[j].x * v[j].x + v[j].y * v[j].y) + (v[j].z * v[j].z + v[j].w * v[j].w); }
    const float rstd = rsqrtf(wave_sum(s) * (1.f / DM) + EPS);
#pragma unroll
    for (int j = 0; j < 8; ++j) { const f32x4 ga = *((const f32x4*)g1 + lane + 64 * j); __builtin_nontemporal_store(v[j] * rstd * ga, (f32x4*)of + lane + 64 * j); }
}
__device__ __forceinline__ void norm_phase(const bf16_t* H, const float* g1, float* of, int gw, int ngw, int lane) {
    for (int m = gw; m < SEQ; m += ngw) norm_row(H + (size_t)m * DM, g1, of + (size_t)m * DM, lane);
}

__device__ __forceinline__ void combine_phase(const _Float16* OD, const float* subln, bf16_t* OB, float lam_full, float out_scale, int gw, int ngw, int lane) {
    typedef _Float16 h4 __attribute__((ext_vector_type(4)));
    const f32x4 gs = *((const f32x4*)subln + lane);
    for (int m = gw; m < SEQ; m += ngw) {
        const h4* a = (const h4*)(OD + (size_t)m * DM) + lane; const h4* b = (const h4*)(OD + (size_t)SEQ * DM + (size_t)m * DM) + lane;
        u32x2* o = (u32x2*)(OB + (size_t)m * DM) + lane;
#pragma unroll
        for (int hd = 0; hd < NH; ++hd) {
            const h4 x = a[64 * hd], y = b[64 * hd];
            f32x4 v; v.x = (float)x.x - lam_full * (float)y.x; v.y = (float)x.y - lam_full * (float)y.y; v.z = (float)x.z - lam_full * (float)y.z; v.w = (float)x.w - lam_full * (float)y.w;
            const float ss = wave_sum((v.x * v.x + v.y * v.y) + (v.z * v.z + v.w * v.w));
            const float sc = rsqrtf(ss * (1.f / VD) + EPS) * out_scale;
            const f32x4 z = v * sc * gs;
            u32x2 w; w.x = cvt_pk_bf16(z.x, z.y); w.y = cvt_pk_bf16(z.z, z.w); o[64 * hd] = w;
        }
    }
}

template <int W, bool F32>
__device__ __forceinline__ void pool_cols(const void* H, const f32x4 g, const LAS float* rstd, int t0, bf16_t* PB, int c4) {
    f32x4 ring[W];
#pragma unroll
    for (int k = 0; k < W - 1; ++k) { const int t = t0 - (W - 1) + k;
        ring[k] = (t >= 0) ? ld4<F32>(H, (size_t)t * DM + c4) * (rstd[t - (t0 - 15)] ) * g : (f32x4){0.f, 0.f, 0.f, 0.f}; }
    for (int tt = 0; tt < 32; tt += W) {
#pragma unroll
        for (int u = 0; u < W; ++u) { const int t = t0 + tt + u;
            const f32x4 cur = ld4<F32>(H, (size_t)t * DM + c4) * rstd[t - (t0 - 15)] * g;
            ring[(W - 1 + u) % W] = cur;
            f32x4 sum = ring[0];
#pragma unroll
            for (int k = 1; k < W; ++k) sum += ring[k];
            const float inv = 1.f / (float)((t + 1) < W ? (t + 1) : W);
            const f32x4 y = sum * inv - cur;
            u32x2 w; w.x = cvt_pk_bf16(y.x, y.y); w.y = cvt_pk_bf16(y.z, y.w);
            *(u32x2*)(PB + (size_t)t * DM + c4) = w; }
    }
}
template <bool F32>
__device__ __forceinline__ void pool_phase(const int tid, LAS unsigned char* lds, const void* H, const float* g, bf16_t* PB, int vcu, int G) {
    const int lane = tid & 63, wid = tid >> 6;
    LAS float* rstd = (LAS float*)lds;
    for (int item = vcu; item < SEQ / 32; item += G) {
        const int t0 = item * 32;
        __syncthreads();
        for (int i = wid; i < 47; i += 8) { const int t = t0 - 15 + i;
            float r = 0.f;
            if (t >= 0) { float s = 0.f;
#pragma unroll
                for (int j = 0; j < 8; ++j) { const f32x4 v = ld4<F32>(H, (size_t)t * DM + (size_t)(lane + 64 * j) * 4); s += (v.x * v.x + v.y * v.y) + (v.z * v.z + v.w * v.w); }
                r = rsqrtf(wave_sum(s) * (1.f / DM) + EPS); }
            if (lane == 0) rstd[i] = r; }
        __syncthreads();
        const int c4 = tid * 4; const f32x4 gv = *(const f32x4*)(g + c4); const int grp = tid >> 7;
        if (grp == 0) pool_cols<2, F32>(H, gv, rstd, t0, PB, c4);
        else if (grp == 1) pool_cols<4, F32>(H, gv, rstd, t0, PB, c4);
        else if (grp == 2) pool_cols<8, F32>(H, gv, rstd, t0, PB, c4);
        else pool_cols<16, F32>(H, gv, rstd, t0, PB, c4);
    }
}

typedef __attribute__((address_space(1))) unsigned gu32;
#define XB_TMO      128
#define XB_XCNT(j)  (256  + 64 * (j))
#define XB_XSUB(j)  (1280 + 64 * (j))
#define XB_XGEN(j)  (2304 + 64 * (j))
#define XB_TOP      3328
#define XB_TOPGEN   3392
#define XCD_BAR_WORDS 3456
#define XB_SPIN_CAP (1u << 18)

__device__ __forceinline__ unsigned xb_ld(unsigned* p)              { return __hip_atomic_load(p, __ATOMIC_RELAXED, __HIP_MEMORY_SCOPE_AGENT); }
__device__ __forceinline__ unsigned xb_add(unsigned* p, unsigned v) { return __hip_atomic_fetch_add(p, v, __ATOMIC_RELAXED, __HIP_MEMORY_SCOPE_AGENT); }
__device__ __forceinline__ unsigned xb_xcc_id() { return (unsigned)__builtin_amdgcn_s_getreg((3 << 11) | 20) & 0xFu; }
#define XB_SPIN(cond, bar) do { unsigned _sp = 0; while (cond) { __builtin_amdgcn_s_sleep(1); \
    if ((++_sp & 255u) == 0u) { if (xb_ld(&(bar)[XB_TMO])) break; if (_sp > XB_SPIN_CAP) { atomicAdd(&(bar)[XB_TMO], 1u); break; } } } } while (0)

struct XcdBarrier {
    unsigned* bar; unsigned x; int wave;
    volatile LAS unsigned* st;
};

__device__ __forceinline__ XcdBarrier xcd_barrier_post(unsigned* bar, volatile LAS unsigned* st) {
    XcdBarrier b; b.bar = bar; b.x = xb_xcc_id(); b.st = st;
    if (threadIdx.x == 0) (void)xb_add(&bar[XB_XCNT(b.x)], 1u);
    return b;
}
__device__ __forceinline__ void xcd_barrier_complete(unsigned* bar, unsigned x, unsigned& nloc, unsigned& nx) {
    const unsigned G = gridDim.x * gridDim.y * gridDim.z;
    unsigned sum, cnt, mine, sp = 0u;
    for (;;) {
        sum = 0u; cnt = 0u; mine = 0u;
#pragma unroll
        for (unsigned j = 0; j < 16; ++j) { const unsigned c = xb_ld(&bar[XB_XCNT(j)]); sum += c; cnt += (c > 0u) ? 1u : 0u; mine = (j == x) ? c : mine; }
        if (sum == G) break;
        __builtin_amdgcn_s_sleep(1);
        if ((++sp & 255u) == 0u) { if (xb_ld(&bar[XB_TMO])) break; if (sp > XB_SPIN_CAP) { atomicAdd(&bar[XB_TMO], 1u); break; } }
    }
    nloc = mine > 0u ? mine : 1u; nx = cnt > 0u ? cnt : 1u;
}

__device__ __forceinline__ void xcd_barrier(const XcdBarrier& b) {
    asm volatile("s_waitcnt vmcnt(0)" ::: "memory");
    __syncthreads();
    int l0_; asm volatile("v_mbcnt_lo_u32_b32 %0, -1, 0\n\tv_mbcnt_hi_u32_b32 %0, -1, %0" : "=v"(l0_));
    if (b.wave == 0 && l0_ == 0) {
        unsigned* bar = b.bar;
        __builtin_amdgcn_s_waitcnt(0);
        unsigned nloc = b.st[0], nx = b.st[1];
        if (nloc == 0u) { xcd_barrier_complete(bar, b.x, nloc, nx); b.st[0] = nloc; b.st[1] = nx; }
        const unsigned old = xb_add(&bar[XB_XSUB(b.x)], 1u);
        const unsigned gen = old / nloc;
        if (old + 1u == (gen + 1u) * nloc) {
            __builtin_amdgcn_fence(__ATOMIC_RELEASE, "agent");
            asm volatile("s_waitcnt vmcnt(0)" ::: "memory");
            const unsigned og = xb_add(&bar[XB_TOP], 1u);
            const unsigned tg = og / nx;
            if (og + 1u == (tg + 1u) * nx) xb_add(&bar[XB_TOPGEN], 1u);
            else XB_SPIN(xb_ld(&bar[XB_TOPGEN]) == tg, bar);
            __builtin_amdgcn_fence(__ATOMIC_ACQUIRE, "agent");
            xb_add(&bar[XB_XGEN(b.x)], 1u);
            asm volatile("s_waitcnt vmcnt(0)" ::: "memory");
        } else {
            XB_SPIN(xb_ld(&bar[XB_XGEN(b.x)]) == gen, bar);
            __builtin_amdgcn_fence(__ATOMIC_ACQUIRE, "agent");
            asm volatile("s_waitcnt vmcnt(0)" ::: "memory");
        }
    }
    __syncthreads();
}

__global__ void __launch_bounds__(512, 2) fwd(Args args) {
    extern __shared__ __attribute__((aligned(16))) unsigned char lds_raw[];
    LAS unsigned char* lds = (LAS unsigned char*)lds_raw;
    const int G = gridDim.x, bx = blockIdx.x, vcu = (G % 8 == 0) ? (bx % 8) * (G / 8) + bx / 8 : bx;
    cg::grid_group grid = cg::this_grid();
    const int wave = __builtin_amdgcn_readfirstlane((int)threadIdx.x >> 6);
    volatile LAS unsigned* bst = (volatile LAS unsigned*)(lds + BAR_LDS_OFF);
    if (threadIdx.x < 16) bst[threadIdx.x] = 0u;
    __syncthreads();
    XcdBarrier bar = xcd_barrier_post((unsigned*)(args.ws + WS_CTL), bst); bar.wave = wave;
    if (args.ph_lo < 0) grid.sync();
    for (int ph = args.ph_lo; ph < args.ph_hi; ++ph) {
        const int gw = vcu * 8 + wave, ngw = G * 8;
#define GET_LANE_TID() int lane; asm volatile("v_mbcnt_lo_u32_b32 %0, -1, 0\n\tv_mbcnt_hi_u32_b32 %0, -1, %0" : "=v"(lane)); const int tid = wave * 64 + lane; (void)tid
        const PhaseDesc& d = args.d[ph];
        const int type = d.type;
        if (type == T_GEMM_RES) {
            GET_LANE_TID();
            pg8::Gemm g{(const bf16_t*)d.p0, (const bf16_t*)d.p1, d.M, d.N, d.K, d.lda, d.ldb, d.grp}; pg8::StaticOrder S; S.init(d.M, d.N, G, bx);
            pg8::EpiRes E{d.p3, d.flag, (const float*)d.p4, (bf16_t*)d.p5, (float*)d.p6}; pg8::gemm_phase(tid, lds, g, S, E);
        } else if (type == T_GEMM_BF16) {
            GET_LANE_TID();
            pg8::Gemm g{(const bf16_t*)d.p0, (const bf16_t*)d.p1, d.M, d.N, d.K, d.lda, d.ldb, d.grp}; pg8::StaticOrder S; S.init(d.M, d.N, G, bx);
            pg8::EpiBf16 E{(bf16_t*)d.p2, d.ldc, d.flag & 1, (const float*)d.p3, (const float*)d.p4, d.f0, (const float*)d.p5, (d.flag >> 1) & 1, (LAS float*)(lds + RL_LDS_OFF)}; pg8::gemm_phase(tid, lds, g, S, E);
        } else if (type == T_NORM) {
            GET_LANE_TID();
            norm_phase((const bf16_t*)d.p0, (const float*)d.p1, (float*)d.p2, gw, ngw, lane);
        } else if (type == T_POOL) {
            GET_LANE_TID();
            pool_phase<false>(tid, lds, d.p0, (const float*)d.p1, (bf16_t*)d.p2, vcu, G);
        } else if (type == T_ATT) {
            GET_LANE_TID();
            unsigned char* ws = args.ws;
            const float lam_init = d.f0;
            const float* lm = (const float*)d.p0;
            float s1 = lm[lane] * lm[HD + lane] + lm[64 + lane] * lm[HD + 64 + lane], s2 = lm[2 * HD + lane] * lm[3 * HD + lane] + lm[2 * HD + 64 + lane] * lm[3 * HD + 64 + lane];
            s1 = wave_sum(s1); s2 = wave_sum(s2);
            const float lam_full = __builtin_bit_cast(float, __builtin_amdgcn_readfirstlane(__builtin_bit_cast(int, expf(s1) - expf(s2) + lam_init)));
            att::Params P{(const bf16_t*)(ws + WS_Q), (const bf16_t*)(ws + WS_K), (const bf16_t*)(ws + WS_VT), (bf16_t*)(ws + WS_O), (const float*)d.p1, lam_full, d.f1};
            for (int pidx = vcu; pidx < 256; pidx += G) { const int h = pidx >> 5, s = pidx & 31;
                att::unit(wave, lds, P, h, 63 - s); att::unit(wave, lds, P, h, s); }
        } else {
            GET_LANE_TID();
            unsigned char* ws = args.ws;
            const float* pool_w = args.in[3]; const float* w_kv = args.in[6]; const float* w_q = args.in[7]; const float* w_o = args.in[10];
            const float* w_in = args.in[11]; const float* w_out = args.in[12];
            bf16_t* WPOOL = (bf16_t*)(ws + WS_WPOOL); bf16_t* WK = (bf16_t*)(ws + WS_WK); bf16_t* WV = (bf16_t*)(ws + WS_WV); bf16_t* WQ = (bf16_t*)(ws + WS_WQ);
            bf16_t* WO = (bf16_t*)(ws + WS_WO); bf16_t* WIN = (bf16_t*)(ws + WS_WIN); bf16_t* WOUT = (bf16_t*)(ws + WS_WOUT);
            float* cosT = (float*)(ws + WS_ROPE); float* sinT = cosT + SEQ * 16;
            LAS unsigned* scr = (LAS unsigned*)(lds + wave * 16384);
            constexpr int I_POOL = 8 * 64, I_SQ = 1024, I_IN = 4096, I_OUT = 4096;
            constexpr int NITEMS = I_POOL + 2 * I_SQ + 2 * I_SQ + 2 * I_SQ + 4 * I_IN + 4 * I_OUT;
            for (int it = gw; it < NITEMS; it += ngw) {
                int r = it;
                if (r < I_POOL) { const int mi = r / 64; transpose_matrix_items(pool_w + (size_t)mi * PG * PG, PG, PG, PG, WPOOL + (size_t)mi * PG * PG, scr, r % 64, lane, nullptr); continue; } r -= I_POOL;
                if (r < I_SQ) { transpose_matrix_items(w_kv, 2 * DM, DM, DM, WK, scr, r, lane, args.in[5]); continue; } r -= I_SQ;
                if (r < I_SQ) { transpose_matrix_items(w_kv + DM, 2 * DM, DM, DM, WV, scr, r, lane, args.in[5]); continue; } r -= I_SQ;
                if (r < 2 * I_SQ) { const int j = r / I_SQ; transpose_matrix_items(w_q + (size_t)j * DM * DM, DM, DM, DM, WQ + (size_t)j * DM * DM, scr, r % I_SQ, lane, args.in[1] + (2 + j) * DM); continue; } r -= 2 * I_SQ;
                if (r < 2 * I_SQ) { const int j = r / I_SQ; transpose_matrix_items(w_o + (size_t)j * DM * DM, DM, DM, DM, WO + (size_t)j * DM * DM, scr, r % I_SQ, lane, nullptr); continue; } r -= 2 * I_SQ;
                if (r < 4 * I_IN) { const int l = r / I_IN; transpose_matrix_items(w_in + (size_t)l * DM * FF, FF, DM, FF, WIN + (size_t)l * DM * FF, scr, r % I_IN, lane, args.in[2] + l * DM); continue; } r -= 4 * I_IN;
                { const int l = r / I_OUT; transpose_matrix_items(w_out + (size_t)l * DM * FF, DM, FF, DM, WOUT + (size_t)l * DM * FF, scr, r % I_OUT, lane, nullptr); }
            }
            for (int i = vcu * 512 + tid; i < SEQ * 16; i += G * 512) {
                const int pos = i >> 4, k = i & 15;
                const float inv_freq = powf(500000.0f, -(float)(2 * k) / 32.0f);
                const float ang = (float)pos * inv_freq;
                cosT[i] = cosf(ang); sinT[i] = sinf(ang);
            }
            pool_phase<true>(tid, lds, args.in[0], args.in[1], (bf16_t*)(ws + WS_XN2), vcu, G);
        }
        if (d.sync && ph + 1 < args.ph_hi) xcd_barrier(bar);
    }
}

static int build_program(Args& a) {
    unsigned char* ws = a.ws;
    const float* x = a.in[0]; const float* mix_norm = a.in[1]; const float* mlp_norm = a.in[2];
    const float* pool_scale = a.in[4]; const float* kv_norm = a.in[5];
    const float* lam = a.in[8]; const float* subln = a.in[9]; const float* final_norm = a.in[13];
    float* cosT = (float*)(ws + WS_ROPE); float* sinT = cosT + SEQ * 16;
    bf16_t* WPOOL = (bf16_t*)(ws + WS_WPOOL); bf16_t* WK = (bf16_t*)(ws + WS_WK); bf16_t* WV = (bf16_t*)(ws + WS_WV); bf16_t* WQ = (bf16_t*)(ws + WS_WQ);
    bf16_t* WO = (bf16_t*)(ws + WS_WO); bf16_t* WIN = (bf16_t*)(ws + WS_WIN); bf16_t* WOUT = (bf16_t*)(ws + WS_WOUT);
    float* H = (float*)(ws + WS_H); bf16_t* XN = (bf16_t*)(ws + WS_XN); bf16_t* XN2 = (bf16_t*)(ws + WS_XN2); bf16_t* U = (bf16_t*)(ws + WS_U);
    bf16_t* KB = (bf16_t*)(ws + WS_K); bf16_t* VT = (bf16_t*)(ws + WS_VT); bf16_t* QB = (bf16_t*)(ws + WS_Q); bf16_t* OB = (bf16_t*)(ws + WS_O);
    int n = 0;
    bf16_t* HB = XN; bf16_t* PB = XN2; float* SSQ = (float*)(ws + WS_SSQ);
    auto gemm_res = [&](const bf16_t* A, const bf16_t* Bt, int M, int N, int K, int lda, int ldb, int grp, const float* base, float* out, const float* cs) {
        PhaseDesc& d = a.d[n++]; d.type = T_GEMM_RES; d.p0 = A; d.p1 = Bt; d.p2 = out; d.p3 = base ? (const void*)base : (const void*)HB; d.flag = base ? 1 : 0; d.p4 = cs; d.p5 = HB; d.p6 = SSQ; d.M = M; d.N = N; d.K = K; d.lda = lda; d.ldb = ldb; d.grp = grp; d.ldc = N; d.sync = 1; };
    auto gemm_bf = [&](const bf16_t* A, const bf16_t* Bt, int M, int N, int K, bf16_t* out, int act, const float* ct, const float* st, float scale, int sync, int colscale) {
        PhaseDesc& d = a.d[n++]; d.type = T_GEMM_BF16; d.p0 = A; d.p1 = Bt; d.p2 = out; d.p3 = ct; d.p4 = st; d.p5 = SSQ; d.M = M; d.N = N; d.K = K; d.lda = K; d.ldb = K; d.grp = 0; d.ldc = N; d.flag = act | (colscale << 1); d.f0 = scale; d.sync = sync; };
    auto norm = [&](const float* Hh, const float* g1, void* o1, const float* g2, bf16_t* o2, int f32out) {
        PhaseDesc& d = a.d[n++]; d.type = T_NORM; d.p0 = Hh; d.p1 = g1; d.p2 = o1; d.p3 = g2; d.p4 = o2; d.flag = f32out; d.sync = 1; };
    { PhaseDesc& d = a.d[n++]; d.type = T_PRO; d.sync = 1; }
    for (int l = 0; l < 2; ++l) {
        gemm_res(PB, WPOOL + (size_t)l * DM * PG, SEQ, DM, PG, DM, PG, 2, l == 0 ? x : nullptr, H, pool_scale + l * DM);
        gemm_bf(HB, WIN + (size_t)l * DM * FF, SEQ, FF, DM, U, 1, nullptr, nullptr, 1.f, 1, 0);
        gemm_res(U, WOUT + (size_t)l * DM * FF, SEQ, DM, FF, FF, FF, 0, nullptr, H, nullptr);
        if (l == 0) { PhaseDesc& d = a.d[n++]; d.type = T_POOL; d.p0 = HB; d.p1 = mix_norm + DM; d.p2 = PB; d.sync = 1; }
    }
    const float qscale = 0.08838834764831845f * 1.4426950408889634f;
    for (int j = 0; j < 2; ++j) {
        const int l = 2 + j;
        if (j == 0) {
            gemm_bf(HB, WK, SEQ, DM, DM, KB, 0, cosT, sinT, 1.f, 0, 0);
            gemm_bf(WV, HB, DM, SEQ, DM, VT, 0, nullptr, nullptr, 1.f, 0, 1);
        }
        gemm_bf(HB, WQ + (size_t)j * DM * DM, SEQ, DM, DM, QB, 0, cosT, sinT, qscale, 1, 0);
        const float lam_init = (float)(0.8 - 0.6 * exp(-0.3 * (double)l));
        { PhaseDesc& d = a.d[n++]; d.type = T_ATT; d.p0 = lam + j * 4 * HD; d.p1 = subln + j * VD; d.f0 = lam_init; d.f1 = 1.f - lam_init; d.sync = 1; }
        gemm_res(OB, WO + (size_t)j * DM * DM, SEQ, DM, DM, DM, DM, 0, nullptr, H, nullptr);
        gemm_bf(HB, WIN + (size_t)l * DM * FF, SEQ, FF, DM, U, 1, nullptr, nullptr, 1.f, 1, 0);
        gemm_res(U, WOUT + (size_t)l * DM * FF, SEQ, DM, FF, FF, FF, 0, nullptr, H, nullptr);
        if (j == 1) norm((const float*)HB, final_norm, a.out, nullptr, nullptr, 1);
    }
    (void)kv_norm; (void)mlp_norm;
    return n;
}

extern "C" void kernel_launch(void* const* d_in, const int* in_sizes, int n_in, void* d_out, int out_size, void* d_ws, size_t ws_size, hipStream_t stream) {
    static int grid = 0;
    if (grid == 0) {
        if (n_in != 14 || out_size != SEQ * DM || ws_size < WS_END) { fprintf(stderr, "kernel_launch: unexpected shapes (n_in %d out %d ws %zu)\n", n_in, out_size, ws_size); grid = -1; return; }
        int dev = 0, cus = 0, per_cu = 0;
        (void)hipGetDevice(&dev); (void)hipDeviceGetAttribute(&cus, hipDeviceAttributeMultiprocessorCount, dev);
        (void)hipFuncSetAttribute((const void*)fwd, hipFuncAttributeMaxDynamicSharedMemorySize, LDS_BYTES);
        (void)hipOccupancyMaxActiveBlocksPerMultiprocessor(&per_cu, (const void*)fwd, 512, LDS_BYTES);
        (void)hipGetLastError();
        if (per_cu < 1) per_cu = 1;
        grid = cus * per_cu;
        if (grid > 256) grid = 256;
    }
    if (grid < 0) return;
    Args a{};
    for (int i = 0; i < 14; ++i) a.in[i] = (const float*)d_in[i];
    a.out = (float*)d_out; a.ws = (unsigned char*)d_ws;
    const int nph = build_program(a);
    (void)hipMemsetAsync((char*)d_ws + WS_CTL, 0, CTL_BYTES, stream);
#if MK_ONE_LAUNCH
    a.ph_lo = 0; a.ph_hi = nph;
    void* kargs[] = {&a};
    hipError_t e = hipLaunchCooperativeKernel((const void*)fwd, dim3(grid), dim3(512), kargs, LDS_BYTES, stream);
    if (e != hipSuccess) fprintf(stderr, "cooperative launch failed: %s (grid %d)\n", hipGetErrorString(e), grid);
#else
    for (int p = 0; p < nph; ++p) { a.ph_lo = p; a.ph_hi = p + 1; hipLaunchKernelGGL(fwd, dim3(grid), dim3(512), LDS_BYTES, stream, a); }
#endif
}
```

```cpp
#include <hip/hip_runtime.h>
#include <hip/hip_cooperative_groups.h>
#include <cstdio>
#include <cstdint>
namespace cg = cooperative_groups;

#ifndef MK_ONE_LAUNCH
#define MK_ONE_LAUNCH 1
#endif

#define LAS __attribute__((address_space(3)))
typedef unsigned short bf16_t;
typedef short bf16x8 __attribute__((ext_vector_type(8)));
typedef float f32x4 __attribute__((ext_vector_type(4)));
typedef float f32x16 __attribute__((ext_vector_type(16)));
typedef unsigned u32x4 __attribute__((ext_vector_type(4)));
typedef unsigned u32x2 __attribute__((ext_vector_type(2)));

constexpr int SEQ = 8192, DM = 2048, FF = 8192, NH = 8, HD = 128, VD = 256, PG = 512;
constexpr float EPS = 1e-6f;
constexpr size_t MiB = 1u << 20;
constexpr size_t WS_ROPE = 1 * MiB, WS_WPOOL = 2 * MiB, WS_WK = 8 * MiB, WS_WV = 16 * MiB, WS_WQ = 24 * MiB, WS_WO = 40 * MiB,
                 WS_WIN = 64 * MiB, WS_WOUT = 192 * MiB, WS_H = 320 * MiB, WS_XN = 384 * MiB, WS_XN2 = 416 * MiB, WS_U = 448 * MiB,
                 WS_K = 576 * MiB, WS_VT = 608 * MiB, WS_Q = 640 * MiB, WS_O = 672 * MiB, WS_END = 704 * MiB;
constexpr int LDS_BYTES = 147456;
constexpr int BAR_LDS_OFF = 147456 - 64, RL_LDS_OFF = 131072;
constexpr size_t WS_SSQ = 6 * MiB;
constexpr size_t WS_CTL = 0, CTL_BYTES = 16384;

__device__ __forceinline__ unsigned cvt_pk_bf16(float lo, float hi) { unsigned r; asm volatile("v_cvt_pk_bf16_f32 %0, %1, %2" : "=v"(r) : "v"(lo), "v"(hi)); return r; }
__device__ __forceinline__ f32x4 bf4_to_f32(u32x2 w) { f32x4 r; r.x = __uint_as_float(w.x << 16); r.y = __uint_as_float(w.x & 0xffff0000u); r.z = __uint_as_float(w.y << 16); r.w = __uint_as_float(w.y & 0xffff0000u); return r; }
template <bool F32> __device__ __forceinline__ f32x4 ld4(const void* base, size_t idx) { if (F32) return *(const f32x4*)((const float*)base + idx); return bf4_to_f32(*(const u32x2*)((const bf16_t*)base + idx)); }
__device__ __forceinline__ float wave_sum(float v) {
#pragma unroll
    for (int o = 1; o < 64; o <<= 1) v += __shfl_xor(v, o);
    return v;
}

namespace pg8 {
constexpr int BM = 256, BK = 64, HALF = 128, HTB = HALF * BK * 2, STAGE_BYTES = 8 * HTB, NXCD = 8, WGM = 8;
__host__ __device__ __forceinline__ int lds_byte(int r, int c) { const int st = (r >> 4) * 2 + (c >> 5), rr = r & 15, cc = c & 31, ob = rr * 64 + cc * 2; return st * 1024 + (ob ^ (((ob >> 9) & 1) << 5)); }
__host__ __device__ __forceinline__ void stage_rc(int b, int& R, int& C) { const int st = b / 1024, sb = b % 1024, swz = sb ^ (((sb >> 9) & 1) << 5); R = (st >> 1) * 16 + swz / 64; C = (st & 1) * 32 + (swz % 64) / 2; }
__host__ __device__ __forceinline__ int perm32(int rho) { const int n = rho >> 4, i = rho & 15; return 8 * (i >> 2) + 4 * n + (i & 3); }

struct Unit { int pm, pn; };
struct Gemm { const bf16_t* A; const bf16_t* Bt; int M, N, K, lda, ldb, grp; };

struct StaticOrder {
    int nM, nN, nwg, G, c;
    __host__ __device__ void init(int M, int N, int G_, int c_) { nM = M / BM; nN = N / BM; nwg = nM * nN; G = G_; c = c_; }
    __host__ __device__ bool next(int i, Unit& u) const {
        const long L = (long)i * G + c; if (L >= nwg) return false;
        int wgid = (int)L; { const int q = nwg / NXCD, r = nwg % NXCD, xcd = wgid % NXCD, off = wgid / NXCD; wgid = (xcd < r ? xcd * (q + 1) : r * (q + 1) + (xcd - r) * q) + off; }
        const int nig = WGM * nN, gid = wgid / nig, fm = gid * WGM, gsz = (nM - fm) < WGM ? (nM - fm) : WGM;
        u.pm = fm + ((wgid % nig) % gsz); u.pn = (wgid % nig) / gsz; return true;
    }
};

struct EpiBf16 {
    static constexpr bool PERM = true;
    bf16_t* O; int ldc; int act; const float* cosT; const float* sinT; float scale; const float* ssq; int colscale; LAS float* rl;
    __device__ __forceinline__ void operator()(const f32x4 (&acc)[2][2][4][2], const Unit& u, int wr, int wc, int fr, int fq) const {
        const int row0 = u.pm * BM + wr * 64 + fr, col0 = u.pn * BM + wc * 32 + 8 * fq;
        const bool rope = (cosT != nullptr) && (wc == 0);
        if (ssq) {
            if (wr == 0) { const int i = wc * 64 + fq * 16 + fr; const f32x4* sp = (const f32x4*)(ssq + (size_t)((colscale ? u.pn : u.pm) * BM + i) * 32);
                f32x4 t = sp[0];
#pragma unroll
                for (int k = 1; k < 8; ++k) t += sp[k];
                rl[i] = rsqrtf(((t.x + t.y) + (t.z + t.w)) * (1.f / DM) + EPS); }
            asm volatile("s_waitcnt lgkmcnt(0)" ::: "memory"); __builtin_amdgcn_s_barrier(); asm volatile("" ::: "memory");
        }
        f32x4 cs0[2], cs1[2];
#pragma unroll
        for (int bj = 0; bj < 2; ++bj) { cs0[bj] = (f32x4){scale, scale, scale, scale}; cs1[bj] = cs0[bj];
            if (ssq && colscale) { const LAS float* rp = rl + bj * HALF + wc * 32 + 8 * fq; cs0[bj] = *(const LAS f32x4*)rp * scale; cs1[bj] = *(const LAS f32x4*)(rp + 4) * scale; } }
#pragma unroll
        for (int ai = 0; ai < 2; ++ai)
#pragma unroll
            for (int m = 0; m < 4; ++m) { const int row = row0 + ai * HALF + m * 16; bf16_t* rowp = O + (size_t)row * ldc + col0;
                const float rs = (ssq && !colscale) ? rl[ai * HALF + wr * 64 + m * 16 + fr] : 1.f;
                f32x4 c0 = {1.f, 1.f, 1.f, 1.f}, c1 = c0, s0 = {0.f, 0.f, 0.f, 0.f}, s1 = s0;
                if (rope) { const float* cp = cosT + (size_t)row * 16 + 8 * (fq & 1); const float* sp = sinT + (size_t)row * 16 + 8 * (fq & 1);
                    c0 = *(const f32x4*)cp; c1 = *(const f32x4*)(cp + 4); s0 = *(const f32x4*)sp; s1 = *(const f32x4*)(sp + 4);
                    if (fq < 2) { s0 = -s0; s1 = -s1; } }
#pragma unroll
                for (int bj = 0; bj < 2; ++bj) { f32x4 v0 = acc[ai][bj][m][0] * rs, v1 = acc[ai][bj][m][1] * rs;
                    if (rope) {
#pragma unroll
                        for (int j = 0; j < 4; ++j) { const float p0 = __shfl_xor(v0[j], 32), p1 = __shfl_xor(v1[j], 32);
                            v0[j] = v0[j] * c0[j] + p0 * s0[j]; v1[j] = v1[j] * c1[j] + p1 * s1[j]; } }
                    v0 = v0 * cs0[bj]; v1 = v1 * cs1[bj];
                    if (act) {
#pragma unroll
                        for (int j = 0; j < 4; ++j) { const float a = fmaxf(v0[j], 0.f), b = fmaxf(v1[j], 0.f); v0[j] = a * a; v1[j] = b * b; } }
                    u32x4 w; w.x = cvt_pk_bf16(v0[0], v0[1]); w.y = cvt_pk_bf16(v0[2], v0[3]); w.z = cvt_pk_bf16(v1[0], v1[1]); w.w = cvt_pk_bf16(v1[2], v1[3]);
                    *(u32x4*)(rowp + bj * HALF) = w; } }
    }
};
struct EpiRes {
    static constexpr bool PERM = false;
    const void* base; int base_f32; const float* cs; bf16_t* hb; float* ssq;
    __device__ __forceinline__ void operator()(const f32x4 (&acc)[2][2][4][2], const Unit& u, int wr, int wc, int fr, int fq) const {
        const int col0 = u.pn * BM + wc * 32 + 4 * fq;
#pragma unroll
        for (int ai = 0; ai < 2; ++ai)
#pragma unroll
            for (int m = 0; m < 4; ++m) { const int row = u.pm * BM + ai * HALF + wr * 64 + m * 16 + fr; const size_t off = (size_t)row * DM + col0;
                float sq = 0.f;
#pragma unroll
                for (int bj = 0; bj < 2; ++bj)
#pragma unroll
                    for (int n = 0; n < 2; ++n) { const f32x4 bs = base_f32 ? ld4<true>(base, off + bj * HALF + n * 16) : ld4<false>(base, off + bj * HALF + n * 16);
                        const f32x4 csv = cs ? *(const f32x4*)(cs + col0 + bj * HALF + n * 16) : (f32x4){1.f, 1.f, 1.f, 1.f};
                        const f32x4 v = bs + acc[ai][bj][m][n] * csv;
                        sq += (v.x * v.x + v.y * v.y) + (v.z * v.z + v.w * v.w);
                        u32x2 w; w.x = cvt_pk_bf16(v.x, v.y); w.y = cvt_pk_bf16(v.z, v.w); *(u32x2*)(hb + off + bj * HALF + n * 16) = w; }
                sq += __shfl_xor(sq, 16); sq += __shfl_xor(sq, 32);
                if (fq == 0) ssq[(size_t)row * 32 + u.pn * 4 + wc] = sq;
                asm volatile("" ::: "memory"); }
    }
};

template <class Epi>
__device__ __forceinline__ void gemm_phase(const int tid, LAS unsigned char* lds, const Gemm g, const StaticOrder& S, const Epi& E) {
    const int wid = __builtin_amdgcn_readfirstlane(tid >> 6), lane = tid & 63, wr = wid >> 2, wc = wid & 3, fr = lane & 15, fq = lane >> 4;
    const int K = g.K, nt = K / BK;
    unsigned voffA[2], voffB[2];
#pragma unroll
    for (int i = 0; i < 2; ++i) { int R, C; stage_rc(tid * 16 + i * 8192, R, C); const int Rb = Epi::PERM ? ((R & ~31) + perm32(R & 31)) : R;
        voffA[i] = (unsigned)(R * g.lda + C) * 2u; voffB[i] = (unsigned)(Rb * g.ldb + C) * 2u; }
    const size_t kstep = (size_t)(BK * 2);
    const size_t hstepA = (size_t)HALF * g.lda * 2, hstepB = (size_t)HALF * g.ldb * 2;
    const size_t tstepA = 2 * hstepA, tstepB = 2 * hstepB;
    const unsigned ldsw = (unsigned)wid * 1024u;
    const int aoff = lds_byte(wr * 64 + fr, fq * 8), boff = lds_byte(wc * 32 + fr, fq * 8);
#define PG8_SA(b, h) (((b) * 2 + (h)) * HTB)
#define PG8_SB(b, h) ((4 + (b) * 2 + (h)) * HTB)
#define PG8_STAGE(bufoff, gbase, voff) do { _Pragma("unroll") for (int _i = 0; _i < 2; ++_i) \
        __builtin_amdgcn_global_load_lds((const unsigned*)((const char*)(gbase) + (voff)[_i]), (LAS unsigned*)(lds + (bufoff) + ldsw + _i * 8192), 16, 0, 0); } while (0)
#define PG8_LDA(dst, b, h) do { _Pragma("unroll") for (int m = 0; m < 4; ++m) _Pragma("unroll") for (int k = 0; k < 2; ++k) dst[m][k] = *(const LAS bf16x8*)(lds + PG8_SA(b, h) + aoff + m * 2048 + k * 1024); } while (0)
#define PG8_LDB(dst, b, h) do { _Pragma("unroll") for (int n = 0; n < 2; ++n) _Pragma("unroll") for (int k = 0; k < 2; ++k) dst[n][k] = *(const LAS bf16x8*)(lds + PG8_SB(b, h) + boff + n * 2048 + k * 1024); } while (0)
#define PG8_MMA(ai, bj, At, Bt) do { __builtin_amdgcn_s_setprio(1); _Pragma("unroll") for (int m = 0; m < 4; ++m) _Pragma("unroll") for (int n = 0; n < 2; ++n) _Pragma("unroll") for (int k = 0; k < 2; ++k) \
        acc[ai][bj][m][n] = __builtin_amdgcn_mfma_f32_16x16x32_bf16(Bt[n][k], At[m][k], acc[ai][bj][m][n], 0, 0, 0); __builtin_amdgcn_s_setprio(0); } while (0)
#define PG8_WAIT_V(n) asm volatile("s_waitcnt vmcnt(" #n ")" ::: "memory")
#define PG8_WAIT_L(n) asm volatile("s_waitcnt lgkmcnt(" #n ")" ::: "memory")
#define PG8_BAR __builtin_amdgcn_s_barrier()
#define PG8_SCHED __builtin_amdgcn_sched_barrier(0)
#define PG8_ABASE(u) ((const char*)g.A + (size_t)(u).pm * tstepA + (g.grp ? (size_t)((u).pn / g.grp) * K * 2 : (size_t)0))
#define PG8_BBASE(u) ((const char*)g.Bt + (size_t)(u).pn * tstepB)
    Unit cur, nxt; int ui = 0;
    if (!S.next(0, cur)) return;
    f32x4 acc[2][2][4][2];
#pragma unroll
    for (int a = 0; a < 2; ++a)
#pragma unroll
        for (int b = 0; b < 2; ++b)
#pragma unroll
            for (int m = 0; m < 4; ++m)
#pragma unroll
                for (int n = 0; n < 2; ++n) acc[a][b][m][n] = (f32x4){0.f, 0.f, 0.f, 0.f};
    bf16x8 At[4][2], B0[2][2], B1[2][2];
    const char* cA = PG8_ABASE(cur); const char* cB = PG8_BBASE(cur);
    PG8_STAGE(PG8_SB(0, 0), cB, voffB); PG8_STAGE(PG8_SB(0, 1), cB + hstepB, voffB); PG8_STAGE(PG8_SA(0, 0), cA, voffA); PG8_STAGE(PG8_SA(0, 1), cA + hstepA, voffA);
    if (wr == 1) PG8_BAR;
    PG8_WAIT_V(2); PG8_BAR;
    PG8_STAGE(PG8_SB(1, 0), cB + kstep, voffB); PG8_STAGE(PG8_SA(1, 0), cA + kstep, voffA); PG8_STAGE(PG8_SB(1, 1), cB + hstepB + kstep, voffB);
    PG8_WAIT_V(6); PG8_BAR;
    for (;;) {
        const bool has_next = S.next(ui + 1, nxt);
        const char* nA = has_next ? PG8_ABASE(nxt) : cA; const char* nB = has_next ? PG8_BBASE(nxt) : cB;
        for (int t = 0; t < nt; t += 2) {
            const bool last = (t == nt - 2);
            const char* a1 = cA + (size_t)(t + 1) * kstep;
            const char* a2 = last ? nA : cA + (size_t)(t + 2) * kstep; const char* b2 = last ? nB : cB + (size_t)(t + 2) * kstep;
            const char* a3 = a2 + kstep; const char* b3 = b2 + kstep;
            PG8_LDB(B0, 0, 0); PG8_LDB(B1, 0, 1); PG8_SCHED; PG8_LDA(At, 0, 0); PG8_STAGE(PG8_SA(1, 1), a1 + hstepA, voffA);
            PG8_WAIT_V(8); PG8_WAIT_L(0); PG8_BAR; PG8_MMA(0, 0, At, B0); PG8_MMA(0, 1, At, B1); PG8_BAR; PG8_SCHED;
            PG8_LDA(At, 0, 1); PG8_STAGE(PG8_SB(0, 0), b2, voffB); PG8_STAGE(PG8_SB(0, 1), b2 + hstepB, voffB); PG8_STAGE(PG8_SA(0, 0), a2, voffA);
            PG8_WAIT_V(8); PG8_WAIT_L(0); PG8_BAR; PG8_MMA(1, 0, At, B0); PG8_MMA(1, 1, At, B1); PG8_BAR; PG8_SCHED;
            PG8_LDB(B0, 1, 0); PG8_LDB(B1, 1, 1); PG8_SCHED; PG8_LDA(At, 1, 0); PG8_STAGE(PG8_SA(0, 1), a2 + hstepA, voffA);
            PG8_WAIT_V(8); PG8_WAIT_L(0); PG8_BAR; PG8_MMA(0, 0, At, B0); PG8_MMA(0, 1, At, B1); PG8_BAR; PG8_SCHED;
            PG8_LDA(At, 1, 1); PG8_STAGE(PG8_SB(1, 0), b3, voffB); PG8_STAGE(PG8_SB(1, 1), b3 + hstepB, voffB); PG8_STAGE(PG8_SA(1, 0), a3, voffA);
            PG8_WAIT_V(8); PG8_WAIT_L(0); PG8_BAR; PG8_MMA(1, 0, At, B0); PG8_MMA(1, 1, At, B1); PG8_BAR; PG8_SCHED;
        }
        if (wr == 0) PG8_BAR;
        { int fr2 = fr, fq2 = fq; asm volatile("" : "+v"(fr2), "+v"(fq2)); E(acc, cur, wr, wc, fr2, fq2); }
        if (!has_next) break;
#pragma unroll
        for (int a = 0; a < 2; ++a)
#pragma unroll
            for (int b = 0; b < 2; ++b)
#pragma unroll
                for (int m = 0; m < 4; ++m)
#pragma unroll
                    for (int n = 0; n < 2; ++n) acc[a][b][m][n] = (f32x4){0.f, 0.f, 0.f, 0.f};
        cur = nxt; cA = nA; cB = nB; ++ui;
        if (wr == 1) PG8_BAR;
    }
    PG8_WAIT_V(0);
    PG8_BAR;
#undef PG8_SA
#undef PG8_SB
#undef PG8_STAGE
#undef PG8_LDA
#undef PG8_LDB
#undef PG8_MMA
#undef PG8_WAIT_V
#undef PG8_WAIT_L
#undef PG8_BAR
#undef PG8_SCHED
#undef PG8_ABASE
#undef PG8_BBASE
}
}

namespace att {
constexpr int KT = 32768, STG = 65536, WSOFF = 131072;
__device__ __forceinline__ int crow(int r, int hi) { return (r & 3) + 8 * (r >> 2) + 4 * hi; }
struct Params { const bf16_t* Q; const bf16_t* K; const bf16_t* VT; bf16_t* O; const float* subln; float lam_full, out_scale; };

__device__ __forceinline__ void unit(const int wid, LAS unsigned char* lds, const Params& P, int h, int qb) {
    int lane; asm volatile("v_mbcnt_lo_u32_b32 %0, -1, 0\n\tv_mbcnt_hi_u32_b32 %0, -1, %0" : "=v"(lane));
    const int r32 = lane & 31, hi = lane >> 5;
    const int c = wid >> 2, rb = wid & 3, q0 = qb * 128, cq = 2 * qb + (rb >> 1), NT = 2 * qb + 2;
    LAS float* wsf = (LAS float*)(lds + WSOFF) + wid * 64;
    unsigned koff0, voff0;
    { const int row = 4 * wid + (lane >> 4), ch = (lane & 15) ^ (row & 15);
      koff0 = (unsigned)((row * DM + (h * 2) * HD + ch * 8) * 2);
      const int e = 8 * wid + (lane >> 3), cv = (lane & 7) ^ ((e >> 1) & 7);
      voff0 = (unsigned)(((h * VD + e) * SEQ + cv * 8) * 2); }
    const char* Kc = (const char*)P.K; const char* Vc = (const char*)P.VT;
#define ATT_ISSUE(t, st) do { _Pragma("unroll") for (int _i = 0; _i < 4; ++_i) { \
        __builtin_amdgcn_global_load_lds((const unsigned*)(Kc + ((size_t)(t) * (64 * DM * 2) + (size_t)((_i & 1) * 32 * DM * 2 + (_i >> 1) * HD * 2)) + koff0), (LAS unsigned*)(lds + (st) * STG + (_i * 8 + wid) * 1024), 16, 0, 0); \
        __builtin_amdgcn_global_load_lds((const unsigned*)(Vc + ((size_t)(t) * 128 + (size_t)_i * (64 * SEQ * 2)) + voff0), (LAS unsigned*)(lds + (st) * STG + KT + (_i * 8 + wid) * 1024), 16, 0, 0); } } while (0)
    ATT_ISSUE(0, 0);
    bf16x8 qr[8];
    { const bf16_t* Qw = P.Q + (size_t)(q0 + 32 * rb + r32) * DM + (h * 2 + c) * HD + hi * 8;
#pragma unroll
      for (int d0 = 0; d0 < 8; ++d0) qr[d0] = *(const bf16x8*)(Qw + d0 * 16); }
    float m_reg = -1e30f, l_reg = 0.f;
    f32x16 o[8];
#pragma unroll
    for (int nb = 0; nb < 8; ++nb)
#pragma unroll
        for (int r = 0; r < 16; ++r) o[nb][r] = 0.f;
    const int ky = (hi ^ (r32 & 15));
    const unsigned kbase = (unsigned)(c * 16384 + r32 * 256);
    const int vsw = hi ^ ((r32 >> 1) & 7);
    const unsigned vbase = (unsigned)(KT + r32 * 128);
    for (int t = 0; t < NT; ++t) {
        asm volatile("s_waitcnt vmcnt(0)" ::: "memory");
        __syncthreads();
        if (t + 1 < NT) ATT_ISSUE(t + 1, (t + 1) & 1);
        if (t <= cq) {
            LAS unsigned char* st = lds + (t & 1) * STG;
            f32x16 p0, p1;
#pragma unroll
            for (int r = 0; r < 16; ++r) { p0[r] = 0.f; p1[r] = 0.f; }
            {
                bf16x8 ka[8];
#define ATT_KRD(d0, hf) (*(const LAS bf16x8*)(st + kbase + (unsigned)(((2 * (d0)) ^ ky) << 4) + (hf) * 8192))
#pragma unroll
                for (int i = 0; i < 4; ++i) { ka[2 * i] = ATT_KRD(i, 0); ka[2 * i + 1] = ATT_KRD(i, 1); }
                __builtin_amdgcn_sched_barrier(0);
#pragma unroll
                for (int i = 0; i < 4; ++i) {
                    p0 = __builtin_amdgcn_mfma_f32_32x32x16_bf16(ka[2 * i], qr[i], p0, 0, 0, 0);
                    p1 = __builtin_amdgcn_mfma_f32_32x32x16_bf16(ka[2 * i + 1], qr[i], p1, 0, 0, 0);
                    ka[2 * i] = ATT_KRD(4 + i, 0); ka[2 * i + 1] = ATT_KRD(4 + i, 1);
                    __builtin_amdgcn_sched_barrier(0);
                }
#pragma unroll
                for (int i = 0; i < 4; ++i) {
                    p0 = __builtin_amdgcn_mfma_f32_32x32x16_bf16(ka[2 * i], qr[4 + i], p0, 0, 0, 0);
                    p1 = __builtin_amdgcn_mfma_f32_32x32x16_bf16(ka[2 * i + 1], qr[4 + i], p1, 0, 0, 0);
                    __builtin_amdgcn_sched_barrier(0);
                }
#undef ATT_KRD
            }
            __builtin_amdgcn_sched_barrier(0);
            float pmax = p0[0];
#pragma unroll
            for (int r = 1; r < 16; ++r) pmax = fmaxf(pmax, p0[r]);
#pragma unroll
            for (int r = 0; r < 16; ++r) pmax = fmaxf(pmax, p1[r]);
            { auto rr = __builtin_amdgcn_permlane32_swap(__float_as_uint(pmax), __float_as_uint(pmax), false, false);
              pmax = fmaxf(__uint_as_float(rr[0]), __uint_as_float(rr[1])); }
            const bool grow = __any(pmax - m_reg > 8.f);
            float alpha = 1.f;
            if (grow) { const float mnew = fmaxf(m_reg, pmax); alpha = __builtin_amdgcn_exp2f(m_reg - mnew); m_reg = mnew; }
            const float mn = m_reg;
#pragma unroll
            for (int r = 0; r < 16; ++r) { p0[r] = __builtin_amdgcn_exp2f(p0[r] - mn); p1[r] = __builtin_amdgcn_exp2f(p1[r] - mn); }
            float ps = 0.f;
#pragma unroll
            for (int r = 0; r < 16; ++r) ps += p0[r] + p1[r];
            { auto rr = __builtin_amdgcn_permlane32_swap(__float_as_uint(ps), __float_as_uint(ps), false, false);
              ps = __uint_as_float(rr[0]) + __uint_as_float(rr[1]); }
            l_reg = l_reg * alpha + ps;
            if (grow) {
                if (hi == 0) wsf[r32] = alpha;
                asm volatile("s_waitcnt lgkmcnt(0)" ::: "memory");
#pragma unroll
                for (int r = 0; r < 16; ++r) { const float al = wsf[crow(r, hi)];
#pragma unroll
                    for (int nb = 0; nb < 8; ++nb) o[nb][r] *= al; }
            }
            __builtin_amdgcn_sched_barrier(0);
            bf16x8 pa[4];
#define ATT_PK4(Pv, BASE, OUT) do { const unsigned a0 = cvt_pk_bf16(Pv[BASE + 0], Pv[BASE + 1]), a1 = cvt_pk_bf16(Pv[BASE + 2], Pv[BASE + 3]); \
            const unsigned b0 = cvt_pk_bf16(Pv[BASE + 4], Pv[BASE + 5]), b1 = cvt_pk_bf16(Pv[BASE + 6], Pv[BASE + 7]); \
            auto r0 = __builtin_amdgcn_permlane32_swap(a0, b0, false, false); auto r1 = __builtin_amdgcn_permlane32_swap(a1, b1, false, false); \
            u32x4 w = {r0[0], r1[0], r0[1], r1[1]}; OUT = __builtin_bit_cast(bf16x8, w); } while (0)
            ATT_PK4(p0, 0, pa[0]); ATT_PK4(p0, 8, pa[1]); ATT_PK4(p1, 0, pa[2]); ATT_PK4(p1, 8, pa[3]);
#undef ATT_PK4
            {
                bf16x8 vf[8];
                __builtin_amdgcn_s_setprio(1);
#define ATT_VRD(s_, nb) (*(const LAS bf16x8*)(st + vbase + (unsigned)(((2 * (s_)) ^ vsw) << 4) + (nb) * 4096))
#pragma unroll
                for (int nb = 0; nb < 8; ++nb) vf[nb] = ATT_VRD(0, nb);
                __builtin_amdgcn_sched_barrier(0);
#pragma unroll
                for (int s = 0; s < 4; ++s) {
#pragma unroll
                    for (int nb = 0; nb < 8; ++nb) {
                        o[nb] = __builtin_amdgcn_mfma_f32_32x32x16_bf16(pa[s], vf[nb], o[nb], 0, 0, 0);
                        if (s < 3) vf[nb] = ATT_VRD(s + 1, nb);
                        if (nb & 1) __builtin_amdgcn_sched_barrier(0);
                    }
                }
#undef ATT_VRD
                __builtin_amdgcn_s_setprio(0);
            }
        }
    }
#undef ATT_ISSUE
    if (hi == 0) wsf[r32] = l_reg;
    asm volatile("s_waitcnt lgkmcnt(0)" ::: "memory");
    int lane2 = lane; asm volatile("" : "+v"(lane2));
    const int r32e = lane2 & 31, hie = lane2 >> 5;
    __syncthreads();
    LAS float* X = (LAS float*)lds + rb * 8192 + lane2;
    if (c == 1) {
#pragma unroll
        for (int r = 0; r < 16; ++r) { const float rl = P.lam_full / wsf[crow(r, hie)];
#pragma unroll
            for (int nb = 0; nb < 8; ++nb) X[(nb * 16 + r) * 64] = o[nb][r] * rl;
            if ((r & 3) == 3) __builtin_amdgcn_sched_barrier(0); }
    }
    __syncthreads();
    if (c == 0) {
        bf16_t* Ob = P.O + (size_t)(q0 + 32 * rb + 4 * hie) * DM + h * VD + r32e;
        float gsub[8];
#pragma unroll
        for (int nb = 0; nb < 8; ++nb) gsub[nb] = P.subln[nb * 32 + r32e] * P.out_scale;
#pragma unroll
        for (int r = 0; r < 16; ++r) { const float rl = 1.f / wsf[crow(r, hie)];
            float v[8], sq = 0.f;
#pragma unroll
            for (int nb = 0; nb < 8; ++nb) { v[nb] = o[nb][r] * rl - X[(nb * 16 + r) * 64]; sq += v[nb] * v[nb]; }
#define ATT_SWZ(v, x) __builtin_bit_cast(float, __builtin_amdgcn_ds_swizzle(__builtin_bit_cast(int, (v)), 0x1f | ((x) << 10)))
            sq += ATT_SWZ(sq, 1); sq += ATT_SWZ(sq, 2); sq += ATT_SWZ(sq, 4); sq += ATT_SWZ(sq, 8); sq += ATT_SWZ(sq, 16);
#undef ATT_SWZ
            const float sc = rsqrtf(sq * (1.f / VD) + EPS);
#pragma unroll
            for (int nb = 0; nb < 8; ++nb) { const unsigned w = cvt_pk_bf16(v[nb] * sc * gsub[nb], 0.f); Ob[(size_t)((r & 3) + 8 * (r >> 2)) * DM + nb * 32] = (bf16_t)(w & 0xffffu); }
            __builtin_amdgcn_sched_barrier(0); }
    }
    __syncthreads();
}
}

enum { T_PRO = 0, T_GEMM_RES = 1, T_GEMM_BF16 = 2, T_NORM = 3, T_POOL = 4, T_ATT = 5, T_COMB = 6 };
struct PhaseDesc { const void* p0; const void* p1; void* p2; const void* p3; const void* p4; void* p5; void* p6; int type, M, N, K, lda, ldb, grp, ldc, flag, sync; float f0, f1; };
constexpr int MAX_PH = 30;
struct Args { const float* in[14]; float* out; unsigned char* ws; int ph_lo, ph_hi; PhaseDesc d[MAX_PH]; };

__device__ __forceinline__ void transpose_item(const float* W, int ldw, bf16_t* WT, int ldt, LAS unsigned* scr, int k0, int n0, int lane, const float* g) {
    const int q = lane >> 4, c4 = (lane & 15) * 4;
    const float* src = W + (size_t)(k0 + 2 * q) * ldw + n0 + c4;
    f32x4 a[8], b[8];
#pragma unroll
    for (int i2 = 0; i2 < 8; ++i2) { a[i2] = *(const f32x4*)(src + (size_t)(8 * i2) * ldw); b[i2] = *(const f32x4*)(src + (size_t)(8 * i2 + 1) * ldw); }
    if (g) {
#pragma unroll
        for (int i2 = 0; i2 < 8; ++i2) { const float ga = g[k0 + 8 * i2 + 2 * q], gb = g[k0 + 8 * i2 + 2 * q + 1]; a[i2] = a[i2] * ga; b[i2] = b[i2] * gb; }
    }
#pragma unroll
    for (int i2 = 0; i2 < 8; ++i2) { LAS unsigned* d = scr + c4 * 33 + 4 * i2 + q;
        d[0 * 33] = cvt_pk_bf16(a[i2].x, b[i2].x); d[1 * 33] = cvt_pk_bf16(a[i2].y, b[i2].y); d[2 * 33] = cvt_pk_bf16(a[i2].z, b[i2].z); d[3 * 33] = cvt_pk_bf16(a[i2].w, b[i2].w); }
    asm volatile("s_waitcnt lgkmcnt(0)" ::: "memory");
    const int c8 = lane & 7;
#pragma unroll
    for (int i = 0; i < 8; ++i) { const int n = (lane >> 3) + 8 * i; const LAS unsigned* sp = scr + n * 33 + 4 * c8;
        u32x4 o; o.x = sp[0]; o.y = sp[1]; o.z = sp[2]; o.w = sp[3];
        *(u32x4*)(WT + (size_t)(n0 + n) * ldt + k0 + 8 * c8) = o; }
    asm volatile("s_waitcnt lgkmcnt(0)" ::: "memory");
}
__device__ __forceinline__ void transpose_matrix_items(const float* src, int ldw, int K, int N, bf16_t* dst, LAS unsigned* scr, int item, int lane, const float* g) {
    const int nblk = N / 64, kb = item / nblk, nb = item % nblk;
    transpose_item(src, ldw, dst, K, scr, 64 * kb, 64 * nb, lane, g);
}

__device__ __forceinline__ void norm_row(const bf16_t* xrow, const float* g1, float* of, int lane) {
    f32x4 v[8]; float s = 0.f;
#pragma unroll
    for (int j = 0; j < 8; ++j) { v[j] = ld4<false>(xrow, (size_t)(lane + 64 * j) * 4); s += (v[j].x * v[j].x + v[j].y * v[j].y) + (v[j].z * v[j].z + v[j].w * v[j].w); }
    const float rstd = rsqrtf(wave_sum(s) * (1.f / DM) + EPS);
#pragma unroll
    for (int j = 0; j < 8; ++j) { const f32x4 ga = *((const f32x4*)g1 + lane + 64 * j); *((f32x4*)of + lane + 64 * j) = v[j] * rstd * ga; }
}
__device__ __forceinline__ void norm_phase(const bf16_t* H, const float* g1, float* of, int gw, int ngw, int lane) {
    for (int m = gw; m < SEQ; m += ngw) norm_row(H + (size_t)m * DM, g1, of + (size_t)m * DM, lane);
}

__device__ __forceinline__ void combine_phase(const _Float16* OD, const float* subln, bf16_t* OB, float lam_full, float out_scale, int gw, int ngw, int lane) {
    typedef _Float16 h4 __attribute__((ext_vector_type(4)));
    const f32x4 gs = *((const f32x4*)subln + lane);
    for (int m = gw; m < SEQ; m += ngw) {
        const h4* a = (const h4*)(OD + (size_t)m * DM) + lane; const h4* b = (const h4*)(OD + (size_t)SEQ * DM + (size_t)m * DM) + lane;
        u32x2* o = (u32x2*)(OB + (size_t)m * DM) + lane;
#pragma unroll
        for (int hd = 0; hd < NH; ++hd) {
            const h4 x = a[64 * hd], y = b[64 * hd];
            f32x4 v; v.x = (float)x.x - lam_full * (float)y.x; v.y = (float)x.y - lam_full * (float)y.y; v.z = (float)x.z - lam_full * (float)y.z; v.w = (float)x.w - lam_full * (float)y.w;
            const float ss = wave_sum((v.x * v.x + v.y * v.y) + (v.z * v.z + v.w * v.w));
            const float sc = rsqrtf(ss * (1.f / VD) + EPS) * out_scale;
            const f32x4 z = v * sc * gs;
            u32x2 w; w.x = cvt_pk_bf16(z.x, z.y); w.y = cvt_pk_bf16(z.z, z.w); o[64 * hd] = w;
        }
    }
}

template <int W, bool F32>
__device__ __forceinline__ void pool_cols(const void* H, const f32x4 g, const LAS float* rstd, int t0, bf16_t* PB, int c4) {
    f32x4 ring[W];
#pragma unroll
    for (int k = 0; k < W - 1; ++k) { const int t = t0 - (W - 1) + k;
        ring[k] = (t >= 0) ? ld4<F32>(H, (size_t)t * DM + c4) * (rstd[t - (t0 - 15)] ) * g : (f32x4){0.f, 0.f, 0.f, 0.f}; }
    for (int tt = 0; tt < 32; tt += W) {
#pragma unroll
        for (int u = 0; u < W; ++u) { const int t = t0 + tt + u;
            const f32x4 cur = ld4<F32>(H, (size_t)t * DM + c4) * rstd[t - (t0 - 15)] * g;
            ring[(W - 1 + u) % W] = cur;
            f32x4 sum = ring[0];
#pragma unroll
            for (int k = 1; k < W; ++k) sum += ring[k];
            const float inv = 1.f / (float)((t + 1) < W ? (t + 1) : W);
            const f32x4 y = sum * inv - cur;
            u32x2 w; w.x = cvt_pk_bf16(y.x, y.y); w.y = cvt_pk_bf16(y.z, y.w);
            *(u32x2*)(PB + (size_t)t * DM + c4) = w; }
    }
}
template <bool F32>
__device__ __forceinline__ void pool_phase(const int tid, LAS unsigned char* lds, const void* H, const float* g, bf16_t* PB, int vcu, int G) {
    const int lane = tid & 63, wid = tid >> 6;
    LAS float* rstd = (LAS float*)lds;
    for (int item = vcu; item < SEQ / 32; item += G) {
        const int t0 = item * 32;
        __syncthreads();
        for (int i = wid; i < 47; i += 8) { const int t = t0 - 15 + i;
            float r = 0.f;
            if (t >= 0) { float s = 0.f;
#pragma unroll
                for (int j = 0; j < 8; ++j) { const f32x4 v = ld4<F32>(H, (size_t)t * DM + (size_t)(lane + 64 * j) * 4); s += (v.x * v.x + v.y * v.y) + (v.z * v.z + v.w * v.w); }
                r = rsqrtf(wave_sum(s) * (1.f / DM) + EPS); }
            if (lane == 0) rstd[i] = r; }
        __syncthreads();
        const int c4 = tid * 4; const f32x4 gv = *(const f32x4*)(g + c4); const int grp = tid >> 7;
        if (grp == 0) pool_cols<2, F32>(H, gv, rstd, t0, PB, c4);
        else if (grp == 1) pool_cols<4, F32>(H, gv, rstd, t0, PB, c4);
        else if (grp == 2) pool_cols<8, F32>(H, gv, rstd, t0, PB, c4);
        else pool_cols<16, F32>(H, gv, rstd, t0, PB, c4);
    }
}

typedef __attribute__((address_space(1))) unsigned gu32;
#define XB_TMO      128
#define XB_XCNT(j)  (256  + 64 * (j))
#define XB_XSUB(j)  (1280 + 64 * (j))
#define XB_XGEN(j)  (2304 + 64 * (j))
#define XB_TOP      3328
#define XB_TOPGEN   3392
#define XCD_BAR_WORDS 3456
#define XB_SPIN_CAP (1u << 18)

__device__ __forceinline__ unsigned xb_ld(unsigned* p)              { return __hip_atomic_load(p, __ATOMIC_RELAXED, __HIP_MEMORY_SCOPE_AGENT); }
__device__ __forceinline__ unsigned xb_add(unsigned* p, unsigned v) { return __hip_atomic_fetch_add(p, v, __ATOMIC_RELAXED, __HIP_MEMORY_SCOPE_AGENT); }
__device__ __forceinline__ unsigned xb_xcc_id() { return (unsigned)__builtin_amdgcn_s_getreg((3 << 11) | 20) & 0xFu; }
#define XB_SPIN(cond, bar) do { unsigned _sp = 0; while (cond) { __builtin_amdgcn_s_sleep(1); \
    if ((++_sp & 255u) == 0u) { if (xb_ld(&(bar)[XB_TMO])) break; if (_sp > XB_SPIN_CAP) { atomicAdd(&(bar)[XB_TMO], 1u); break; } } } } while (0)

struct XcdBarrier {
    unsigned* bar; unsigned x; int wave;
    volatile LAS unsigned* st;
};

__device__ __forceinline__ XcdBarrier xcd_barrier_post(unsigned* bar, volatile LAS unsigned* st) {
    XcdBarrier b; b.bar = bar; b.x = xb_xcc_id(); b.st = st;
    if (threadIdx.x == 0) (void)xb_add(&bar[XB_XCNT(b.x)], 1u);
    return b;
}
__device__ __forceinline__ void xcd_barrier_complete(unsigned* bar, unsigned x, unsigned& nloc, unsigned& nx) {
    const unsigned G = gridDim.x * gridDim.y * gridDim.z;
    unsigned sum, cnt, mine, sp = 0u;
    for (;;) {
        sum = 0u; cnt = 0u; mine = 0u;
#pragma unroll
        for (unsigned j = 0; j < 16; ++j) { const unsigned c = xb_ld(&bar[XB_XCNT(j)]); sum += c; cnt += (c > 0u) ? 1u : 0u; mine = (j == x) ? c : mine; }
        if (sum == G) break;
        __builtin_amdgcn_s_sleep(1);
        if ((++sp & 255u) == 0u) { if (xb_ld(&bar[XB_TMO])) break; if (sp > XB_SPIN_CAP) { atomicAdd(&bar[XB_TMO], 1u); break; } }
    }
    nloc = mine > 0u ? mine : 1u; nx = cnt > 0u ? cnt : 1u;
}

__device__ __forceinline__ void xcd_barrier(const XcdBarrier& b) {
    asm volatile("s_waitcnt vmcnt(0)" ::: "memory");
    __syncthreads();
    int l0_; asm volatile("v_mbcnt_lo_u32_b32 %0, -1, 0\n\tv_mbcnt_hi_u32_b32 %0, -1, %0" : "=v"(l0_));
    if (b.wave == 0 && l0_ == 0) {
        unsigned* bar = b.bar;
        __builtin_amdgcn_s_waitcnt(0);
        unsigned nloc = b.st[0], nx = b.st[1];
        if (nloc == 0u) { xcd_barrier_complete(bar, b.x, nloc, nx); b.st[0] = nloc; b.st[1] = nx; }
        const unsigned old = xb_add(&bar[XB_XSUB(b.x)], 1u);
        const unsigned gen = old / nloc;
        if (old + 1u == (gen + 1u) * nloc) {
            __builtin_amdgcn_fence(__ATOMIC_RELEASE, "agent");
            asm volatile("s_waitcnt vmcnt(0)" ::: "memory");
            const unsigned og = xb_add(&bar[XB_TOP], 1u);
            const unsigned tg = og / nx;
            if (og + 1u == (tg + 1u) * nx) xb_add(&bar[XB_TOPGEN], 1u);
            else XB_SPIN(xb_ld(&bar[XB_TOPGEN]) == tg, bar);
            __builtin_amdgcn_fence(__ATOMIC_ACQUIRE, "agent");
            xb_add(&bar[XB_XGEN(b.x)], 1u);
            asm volatile("s_waitcnt vmcnt(0)" ::: "memory");
        } else {
            XB_SPIN(xb_ld(&bar[XB_XGEN(b.x)]) == gen, bar);
            __builtin_amdgcn_fence(__ATOMIC_ACQUIRE, "agent");
            asm volatile("s_waitcnt vmcnt(0)" ::: "memory");
        }
    }
    __syncthreads();
}

__global__ void __launch_bounds__(512, 2) fwd(Args args) {
    extern __shared__ __attribute__((aligned(16))) unsigned char lds_raw[];
    LAS unsigned char* lds = (LAS unsigned char*)lds_raw;
    const int G = gridDim.x, bx = blockIdx.x, vcu = (G % 8 == 0) ? (bx % 8) * (G / 8) + bx / 8 : bx;
    cg::grid_group grid = cg::this_grid();
    const int wave = __builtin_amdgcn_readfirstlane((int)threadIdx.x >> 6);
    volatile LAS unsigned* bst = (volatile LAS unsigned*)(lds + BAR_LDS_OFF);
    if (threadIdx.x < 16) bst[threadIdx.x] = 0u;
    __syncthreads();
    XcdBarrier bar = xcd_barrier_post((unsigned*)(args.ws + WS_CTL), bst); bar.wave = wave;
    if (args.ph_lo < 0) grid.sync();
    for (int ph = args.ph_lo; ph < args.ph_hi; ++ph) {
        const int gw = vcu * 8 + wave, ngw = G * 8;
#define GET_LANE_TID() int lane; asm volatile("v_mbcnt_lo_u32_b32 %0, -1, 0\n\tv_mbcnt_hi_u32_b32 %0, -1, %0" : "=v"(lane)); const int tid = wave * 64 + lane; (void)tid
        const PhaseDesc& d = args.d[ph];
        const int type = d.type;
        if (type == T_GEMM_RES) {
            GET_LANE_TID();
            pg8::Gemm g{(const bf16_t*)d.p0, (const bf16_t*)d.p1, d.M, d.N, d.K, d.lda, d.ldb, d.grp}; pg8::StaticOrder S; S.init(d.M, d.N, G, bx);
            pg8::EpiRes E{d.p3, d.flag, (const float*)d.p4, (bf16_t*)d.p5, (float*)d.p6}; pg8::gemm_phase(tid, lds, g, S, E);
        } else if (type == T_GEMM_BF16) {
            GET_LANE_TID();
            pg8::Gemm g{(const bf16_t*)d.p0, (const bf16_t*)d.p1, d.M, d.N, d.K, d.lda, d.ldb, d.grp}; pg8::StaticOrder S; S.init(d.M, d.N, G, bx);
            pg8::EpiBf16 E{(bf16_t*)d.p2, d.ldc, d.flag & 1, (const float*)d.p3, (const float*)d.p4, d.f0, (const float*)d.p5, (d.flag >> 1) & 1, (LAS float*)(lds + RL_LDS_OFF)}; pg8::gemm_phase(tid, lds, g, S, E);
        } else if (type == T_NORM) {
            GET_LANE_TID();
            norm_phase((const bf16_t*)d.p0, (const float*)d.p1, (float*)d.p2, gw, ngw, lane);
        } else if (type == T_POOL) {
            GET_LANE_TID();
            pool_phase<false>(tid, lds, d.p0, (const float*)d.p1, (bf16_t*)d.p2, vcu, G);
        } else if (type == T_ATT) {
            GET_LANE_TID();
            unsigned char* ws = args.ws;
            const float lam_init = d.f0;
            const float* lm = (const float*)d.p0;
            float s1 = lm[lane] * lm[HD + lane] + lm[64 + lane] * lm[HD + 64 + lane], s2 = lm[2 * HD + lane] * lm[3 * HD + lane] + lm[2 * HD + 64 + lane] * lm[3 * HD + 64 + lane];
            s1 = wave_sum(s1); s2 = wave_sum(s2);
            const float lam_full = __builtin_bit_cast(float, __builtin_amdgcn_readfirstlane(__builtin_bit_cast(int, expf(s1) - expf(s2) + lam_init)));
            att::Params P{(const bf16_t*)(ws + WS_Q), (const bf16_t*)(ws + WS_K), (const bf16_t*)(ws + WS_VT), (bf16_t*)(ws + WS_O), (const float*)d.p1, lam_full, d.f1};
            for (int pidx = vcu; pidx < 256; pidx += G) { const int h = pidx >> 5, s = pidx & 31;
                att::unit(wave, lds, P, h, 63 - s); att::unit(wave, lds, P, h, s); }
        } else {
            GET_LANE_TID();
            unsigned char* ws = args.ws;
            const float* pool_w = args.in[3]; const float* w_kv = args.in[6]; const float* w_q = args.in[7]; const float* w_o = args.in[10];
            const float* w_in = args.in[11]; const float* w_out = args.in[12];
            bf16_t* WPOOL = (bf16_t*)(ws + WS_WPOOL); bf16_t* WK = (bf16_t*)(ws + WS_WK); bf16_t* WV = (bf16_t*)(ws + WS_WV); bf16_t* WQ = (bf16_t*)(ws + WS_WQ);
            bf16_t* WO = (bf16_t*)(ws + WS_WO); bf16_t* WIN = (bf16_t*)(ws + WS_WIN); bf16_t* WOUT = (bf16_t*)(ws + WS_WOUT);
            float* cosT = (float*)(ws + WS_ROPE); float* sinT = cosT + SEQ * 16;
            LAS unsigned* scr = (LAS unsigned*)(lds + wave * 16384);
            constexpr int I_POOL = 8 * 64, I_SQ = 1024, I_IN = 4096, I_OUT = 4096;
            constexpr int NITEMS = I_POOL + 2 * I_SQ + 2 * I_SQ + 2 * I_SQ + 4 * I_IN + 4 * I_OUT;
            for (int it = gw; it < NITEMS; it += ngw) {
                int r = it;
                if (r < I_POOL) { const int mi = r / 64; transpose_matrix_items(pool_w + (size_t)mi * PG * PG, PG, PG, PG, WPOOL + (size_t)mi * PG * PG, scr, r % 64, lane, nullptr); continue; } r -= I_POOL;
                if (r < I_SQ) { transpose_matrix_items(w_kv, 2 * DM, DM, DM, WK, scr, r, lane, args.in[5]); continue; } r -= I_SQ;
                if (r < I_SQ) { transpose_matrix_items(w_kv + DM, 2 * DM, DM, DM, WV, scr, r, lane, args.in[5]); continue; } r -= I_SQ;
                if (r < 2 * I_SQ) { const int j = r / I_SQ; transpose_matrix_items(w_q + (size_t)j * DM * DM, DM, DM, DM, WQ + (size_t)j * DM * DM, scr, r % I_SQ, lane, args.in[1] + (2 + j) * DM); continue; } r -= 2 * I_SQ;
                if (r < 2 * I_SQ) { const int j = r / I_SQ; transpose_matrix_items(w_o + (size_t)j * DM * DM, DM, DM, DM, WO + (size_t)j * DM * DM, scr, r % I_SQ, lane, nullptr); continue; } r -= 2 * I_SQ;
                if (r < 4 * I_IN) { const int l = r / I_IN; transpose_matrix_items(w_in + (size_t)l * DM * FF, FF, DM, FF, WIN + (size_t)l * DM * FF, scr, r % I_IN, lane, args.in[2] + l * DM); continue; } r -= 4 * I_IN;
                { const int l = r / I_OUT; transpose_matrix_items(w_out + (size_t)l * DM * FF, DM, FF, DM, WOUT + (size_t)l * DM * FF, scr, r % I_OUT, lane, nullptr); }
            }
            for (int i = vcu * 512 + tid; i < SEQ * 16; i += G * 512) {
                const int pos = i >> 4, k = i & 15;
                const float inv_freq = powf(500000.0f, -(float)(2 * k) / 32.0f);
                const float ang = (float)pos * inv_freq;
                cosT[i] = cosf(ang); sinT[i] = sinf(ang);
            }
            pool_phase<true>(tid, lds, args.in[0], args.in[1], (bf16_t*)(ws + WS_XN2), vcu, G);
        }
        if (d.sync && ph + 1 < args.ph_hi) xcd_barrier(bar);
    }
}

static int build_program(Args& a) {
    unsigned char* ws = a.ws;
    const float* x = a.in[0]; const float* mix_norm = a.in[1]; const float* mlp_norm = a.in[2];
    const float* pool_scale = a.in[4]; const float* kv_norm = a.in[5];
    const float* lam = a.in[8]; const float* subln = a.in[9]; const float* final_norm = a.in[13];
    float* cosT = (float*)(ws + WS_ROPE); float* sinT = cosT + SEQ * 16;
    bf16_t* WPOOL = (bf16_t*)(ws + WS_WPOOL); bf16_t* WK = (bf16_t*)(ws + WS_WK); bf16_t* WV = (bf16_t*)(ws + WS_WV); bf16_t* WQ = (bf16_t*)(ws + WS_WQ);
    bf16_t* WO = (bf16_t*)(ws + WS_WO); bf16_t* WIN = (bf16_t*)(ws + WS_WIN); bf16_t* WOUT = (bf16_t*)(ws + WS_WOUT);
    float* H = (float*)(ws + WS_H); bf16_t* XN = (bf16_t*)(ws + WS_XN); bf16_t* XN2 = (bf16_t*)(ws + WS_XN2); bf16_t* U = (bf16_t*)(ws + WS_U);
    bf16_t* KB = (bf16_t*)(ws + WS_K); bf16_t* VT = (bf16_t*)(ws + WS_VT); bf16_t* QB = (bf16_t*)(ws + WS_Q); bf16_t* OB = (bf16_t*)(ws + WS_O);
    int n = 0;
    bf16_t* HB = XN; bf16_t* PB = XN2; float* SSQ = (float*)(ws + WS_SSQ);
    auto gemm_res = [&](const bf16_t* A, const bf16_t* Bt, int M, int N, int K, int lda, int ldb, int grp, const float* base, float* out, const float* cs) {
        PhaseDesc& d = a.d[n++]; d.type = T_GEMM_RES; d.p0 = A; d.p1 = Bt; d.p2 = out; d.p3 = base ? (const void*)base : (const void*)HB; d.flag = base ? 1 : 0; d.p4 = cs; d.p5 = HB; d.p6 = SSQ; d.M = M; d.N = N; d.K = K; d.lda = lda; d.ldb = ldb; d.grp = grp; d.ldc = N; d.sync = 1; };
    auto gemm_bf = [&](const bf16_t* A, const bf16_t* Bt, int M, int N, int K, bf16_t* out, int act, const float* ct, const float* st, float scale, int sync, int colscale) {
        PhaseDesc& d = a.d[n++]; d.type = T_GEMM_BF16; d.p0 = A; d.p1 = Bt; d.p2 = out; d.p3 = ct; d.p4 = st; d.p5 = SSQ; d.M = M; d.N = N; d.K = K; d.lda = K; d.ldb = K; d.grp = 0; d.ldc = N; d.flag = act | (colscale << 1); d.f0 = scale; d.sync = sync; };
    auto norm = [&](const float* Hh, const float* g1, void* o1, const float* g2, bf16_t* o2, int f32out) {
        PhaseDesc& d = a.d[n++]; d.type = T_NORM; d.p0 = Hh; d.p1 = g1; d.p2 = o1; d.p3 = g2; d.p4 = o2; d.flag = f32out; d.sync = 1; };
    { PhaseDesc& d = a.d[n++]; d.type = T_PRO; d.sync = 1; }
    for (int l = 0; l < 2; ++l) {
        gemm_res(PB, WPOOL + (size_t)l * DM * PG, SEQ, DM, PG, DM, PG, 2, l == 0 ? x : nullptr, H, pool_scale + l * DM);
        gemm_bf(HB, WIN + (size_t)l * DM * FF, SEQ, FF, DM, U, 1, nullptr, nullptr, 1.f, 1, 0);
        gemm_res(U, WOUT + (size_t)l * DM * FF, SEQ, DM, FF, FF, FF, 0, nullptr, H, nullptr);
        if (l == 0) { PhaseDesc& d = a.d[n++]; d.type = T_POOL; d.p0 = HB; d.p1 = mix_norm + DM; d.p2 = PB; d.sync = 1; }
    }
    const float qscale = 0.08838834764831845f * 1.4426950408889634f;
    for (int j = 0; j < 2; ++j) {
        const int l = 2 + j;
        if (j == 0) {
            gemm_bf(HB, WK, SEQ, DM, DM, KB, 0, cosT, sinT, 1.f, 0, 0);
            gemm_bf(WV, HB, DM, SEQ, DM, VT, 0, nullptr, nullptr, 1.f, 0, 1);
        }
        gemm_bf(HB, WQ + (size_t)j * DM * DM, SEQ, DM, DM, QB, 0, cosT, sinT, qscale, 1, 0);
        const float lam_init = (float)(0.8 - 0.6 * exp(-0.3 * (double)l));
        { PhaseDesc& d = a.d[n++]; d.type = T_ATT; d.p0 = lam + j * 4 * HD; d.p1 = subln + j * VD; d.f0 = lam_init; d.f1 = 1.f - lam_init; d.sync = 1; }
        gemm_res(OB, WO + (size_t)j * DM * DM, SEQ, DM, DM, DM, DM, 0, nullptr, H, nullptr);
        gemm_bf(HB, WIN + (size_t)l * DM * FF, SEQ, FF, DM, U, 1, nullptr, nullptr, 1.f, 1, 0);
        gemm_res(U, WOUT + (size_t)l * DM * FF, SEQ, DM, FF, FF, FF, 0, nullptr, H, nullptr);
        if (j == 1) norm((const float*)HB, final_norm, a.out, nullptr, nullptr, 1);
    }
    (void)kv_norm; (void)mlp_norm;
    return n;
}

extern "C" void kernel_launch(void* const* d_in, const int* in_sizes, int n_in, void* d_out, int out_size, void* d_ws, size_t ws_size, hipStream_t stream) {
    static int grid = 0;
    if (grid == 0) {
        if (n_in != 14 || out_size != SEQ * DM || ws_size < WS_END) { fprintf(stderr, "kernel_launch: unexpected shapes (n_in %d out %d ws %zu)\n", n_in, out_size, ws_size); grid = -1; return; }
        int dev = 0, cus = 0, per_cu = 0;
        (void)hipGetDevice(&dev); (void)hipDeviceGetAttribute(&cus, hipDeviceAttributeMultiprocessorCount, dev);
        (void)hipFuncSetAttribute((const void*)fwd, hipFuncAttributeMaxDynamicSharedMemorySize, LDS_BYTES);
        (void)hipOccupancyMaxActiveBlocksPerMultiprocessor(&per_cu, (const void*)fwd, 512, LDS_BYTES);
        (void)hipGetLastError();
        if (per_cu < 1) per_cu = 1;
        grid = cus * per_cu;
        if (grid > 256) grid = 256;
    }
    if (grid < 0) return;
    Args a{};
    for (int i = 0; i < 14; ++i) a.in[i] = (const float*)d_in[i];
    a.out = (float*)d_out; a.ws = (unsigned char*)d_ws;
    const int nph = build_program(a);
    (void)hipMemsetAsync((char*)d_ws + WS_CTL, 0, CTL_BYTES, stream);
#if MK_ONE_LAUNCH
    a.ph_lo = 0; a.ph_hi = nph;
    void* kargs[] = {&a};
    hipError_t e = hipLaunchCooperativeKernel((const void*)fwd, dim3(grid), dim3(512), kargs, LDS_BYTES, stream);
    if (e != hipSuccess) fprintf(stderr, "cooperative launch failed: %s (grid %d)\n", hipGetErrorString(e), grid);
#else
    for (int p = 0; p < nph; ++p) { a.ph_lo = p; a.ph_hi = p + 1; hipLaunchKernelGGL(fwd, dim3(grid), dim3(512), LDS_BYTES, stream, a); }
#endif
}
```
